# Optimizing an MI355X kernel written in HIP

```python
import jax, jax.numpy as jnp
from jax import lax
import numpy as np

D_MODEL = 2048
BATCH = 16
SEQ = 2048
DEPTH = 2

WIDTH_POOL = D_MODEL // 4
WIDTH_CONV = (3 * D_MODEL) // 8
WIDTH_SGU = D_MODEL - WIDTH_POOL - WIDTH_CONV
POOL_WINDOWS = (2, 4, 8, 16)
N_POOL_GROUPS = len(POOL_WINDOWS)
POOL_GROUP_DIM = WIDTH_POOL // N_POOL_GROUPS
CONV_WIDTH = 31
N_SGU_HEADS = 6
SGU_HEAD_DIM = WIDTH_SGU // N_SGU_HEADS
CHUNK = 128
D_FF = 4 * D_MODEL
IN_WIDTH = WIDTH_POOL + 2 * WIDTH_CONV + 2 * WIDTH_SGU
N_MOD = 6
LN_EPS = 1e-5
ALPHA = (2.0 * DEPTH) ** 0.25
BETA = (8.0 * DEPTH) ** -0.25
MOD_INIT = 0.5

kernel_name = 'hybrid_pool_conv_sgu_deepnorm_block'


def _layer_norm(x, g, b):
    xf = x.astype(jnp.float32)
    mu = jnp.mean(xf, axis=-1, keepdims=True)
    var = jnp.mean(jnp.square(xf - mu), axis=-1, keepdims=True)
    y = (xf - mu) * lax.rsqrt(var + LN_EPS)
    return (y * g.astype(jnp.float32) + b.astype(jnp.float32)).astype(x.dtype)


def _causal_mean_minus_self(a, window):
    S = a.shape[1]
    af = a.astype(jnp.float32)
    cs = jnp.cumsum(af, axis=1)
    lagged = jnp.pad(cs, ((0, 0), (window, 0), (0, 0)))[:, :S]
    count = jnp.minimum(jnp.arange(1, S + 1, dtype=jnp.float32), float(window))
    mean = (cs - lagged) / count[None, :, None]
    return (mean - af).astype(a.dtype)


def _pool_mixer(a, w_grp, ls):
    B, S, _ = a.shape
    a = a.reshape(B, S, N_POOL_GROUPS, POOL_GROUP_DIM)
    pooled = jnp.stack([_causal_mean_minus_self(a[:, :, g], w) for g, w in enumerate(POOL_WINDOWS)], axis=2)
    y = jnp.einsum('bsgc,gcd->bsgd', pooled, w_grp)
    return y.reshape(B, S, WIDTH_POOL) * ls


def _conv_module(val, gate, conv_w, conv_b, ln_g, ln_b):
    h = val * jax.nn.sigmoid(gate)
    h = lax.conv_general_dilated(
        h, conv_w[:, None, :].astype(h.dtype), window_strides=(1,),
        padding=[(CONV_WIDTH - 1, 0)],
        dimension_numbers=('NWC', 'WIO', 'NWC'),
        feature_group_count=WIDTH_CONV) + conv_b
    h = _layer_norm(h, ln_g, ln_b)
    return jax.nn.silu(h)


def _sgu(z, w_s, b_s, ln_g, ln_b):
    z = jax.nn.gelu(z, approximate=False)
    u, v = jnp.split(z, 2, axis=-1)
    v = _layer_norm(v, ln_g, ln_b)
    B, S, _ = v.shape
    n_chunks = S // CHUNK
    v = v.reshape(B, n_chunks, CHUNK, N_SGU_HEADS, SGU_HEAD_DIM)
    mask = jnp.tril(jnp.ones((CHUNK, CHUNK), dtype=w_s.dtype))
    v = jnp.einsum('hts,bnshd->bnthd', w_s * mask, v) + b_s.T[:, :, None]
    return u * v.reshape(B, S, WIDTH_SGU)


def setup_inputs(seed: int = 0) -> dict:
    key = jax.random.key(seed)
    ks = jax.random.split(key, 24)
    f32 = jnp.float32
    nrm = lambda k, shape, s: jax.random.normal(k, shape, f32) * s
    L, D = DEPTH, D_MODEL
    return {
        'x': nrm(ks[0], (BATCH, SEQ, D), 1.0),
        'c': nrm(ks[1], (BATCH, D), 1.0),
        'w_mod': nrm(ks[2], (L, D, N_MOD * D), MOD_INIT * D ** -0.5),
        'b_mod': nrm(ks[3], (L, N_MOD * D), 0.02),
        'w_in': nrm(ks[4], (L, D, IN_WIDTH), D ** -0.5),
        'w_pool': nrm(ks[5], (L, N_POOL_GROUPS, POOL_GROUP_DIM, POOL_GROUP_DIM), POOL_GROUP_DIM ** -0.5),
        'ls_pool': 1.0 + nrm(ks[6], (L, WIDTH_POOL), 0.02),
        'conv_w': nrm(ks[7], (L, CONV_WIDTH, WIDTH_CONV), CONV_WIDTH ** -0.5),
        'conv_b': nrm(ks[8], (L, WIDTH_CONV), 0.02),
        'ln_conv_g': 1.0 + nrm(ks[9], (L, WIDTH_CONV), 0.02),
        'ln_conv_b': nrm(ks[10], (L, WIDTH_CONV), 0.02),
        'w_sgu': nrm(ks[11], (L, N_SGU_HEADS, CHUNK, CHUNK), CHUNK ** -0.5),
        'b_sgu': 1.0 + nrm(ks[12], (L, N_SGU_HEADS, CHUNK), 0.02),
        'ln_sgu_g': 1.0 + nrm(ks[13], (L, WIDTH_SGU), 0.02),
        'ln_sgu_b': nrm(ks[14], (L, WIDTH_SGU), 0.02),
        'w_out': nrm(ks[15], (L, D, D), BETA * D ** -0.5),
        'ln_mix_g': 1.0 + nrm(ks[16], (L, D), 0.02),
        'ln_mix_b': nrm(ks[17], (L, D), 0.02),
        'w_ff1': nrm(ks[18], (L, D, D_FF), D ** -0.5),
        'w_ff2': nrm(ks[19], (L, D_FF, D), BETA * D_FF ** -0.5),
        'ln_ff_g': 1.0 + nrm(ks[20], (L, D), 0.02),
        'ln_ff_b': nrm(ks[21], (L, D), 0.02),
    }


def reference(x, c, w_mod, b_mod, w_in, w_pool, ls_pool, conv_w, conv_b, ln_conv_g, ln_conv_b,
              w_sgu, b_sgu, ln_sgu_g, ln_sgu_b, w_out, ln_mix_g, ln_mix_b,
              w_ff1, w_ff2, ln_ff_g, ln_ff_b):
    c_act = jax.nn.silu(c)
    split_at = [WIDTH_POOL, WIDTH_POOL + WIDTH_CONV, WIDTH_POOL + 2 * WIDTH_CONV]
    for l in range(DEPTH):
        mod = c_act @ w_mod[l] + b_mod[l]
        sh_m, sc_m, g_m, sh_f, sc_f, g_f = [m[:, None, :] for m in jnp.split(mod, N_MOD, axis=-1)]

        h = x * (1.0 + sc_m) + sh_m
        p = h @ w_in[l]
        a, val, gate, z = jnp.split(p, split_at, axis=-1)
        y_pool = _pool_mixer(a, w_pool[l], ls_pool[l])
        y_conv = _conv_module(val, gate, conv_w[l], conv_b[l], ln_conv_g[l], ln_conv_b[l])
        y_sgu = _sgu(z, w_sgu[l], b_sgu[l], ln_sgu_g[l], ln_sgu_b[l])
        y = jnp.concatenate([y_pool, y_conv, y_sgu], axis=-1) @ w_out[l]
        x = _layer_norm(ALPHA * x + g_m * y, ln_mix_g[l], ln_mix_b[l])

        h = x * (1.0 + sc_f) + sh_f
        f = jnp.square(jax.nn.relu(h @ w_ff1[l])) @ w_ff2[l]
        x = _layer_norm(ALPHA * x + g_f * f, ln_ff_g[l], ln_ff_b[l])
    return x
```

```cpp
#include <hip/hip_runtime.h>
#include <hip/hip_cooperative_groups.h>
#include <cstdio>
#include <cstdint>
namespace cg = cooperative_groups;

namespace pg8 {
#define PG8_LAS __attribute__((address_space(3)))
typedef unsigned short bf16_t;
typedef short bf16x8 __attribute__((ext_vector_type(8)));
typedef float f32x4 __attribute__((ext_vector_type(4)));
typedef unsigned u32x4 __attribute__((ext_vector_type(4)));
constexpr int BM = 256, BK = 64, HALF = 128, HTB = HALF * BK * 2  , STAGE_BYTES = 8 * HTB, NXCD = 8, WGM = 8;

__host__ __device__ __forceinline__ int lds_byte(int r, int c) { const int st = (r >> 4) * 2 + (c >> 5), rr = r & 15, cc = c & 31, ob = rr * 64 + cc * 2; return st * 1024 + (ob ^ (((ob >> 9) & 1) << 5)); }
__host__ __device__ __forceinline__ void stage_rc(int b, int& R, int& C) { const int st = b / 1024, sb = b % 1024, swz = sb ^ (((sb >> 9) & 1) << 5); R = (st >> 1) * 16 + swz / 64; C = (st & 1) * 32 + (swz % 64) / 2; }
__host__ __device__ __forceinline__ int perm32(int rho) { const int n = rho >> 4, i = rho & 15; return 8 * (i >> 2) + 4 * n + (i & 3); }

struct Unit { int pm, pn; };
struct Gemm { const bf16_t* A; const bf16_t* Bt; int M, N, K; };

struct StaticOrder {
    int nM, nN, nwg, G, c;
    __host__ __device__ void init(int M, int N, int G_, int c_) { nM = M / BM; nN = N / BM; nwg = nM * nN; G = G_; c = c_; }
    __host__ __device__ bool next(int i, Unit& u) const {
        const long L = (long)i * G + c; if (L >= nwg) return false;
        int wgid = (int)L; { const int q = nwg / NXCD, r = nwg % NXCD, xcd = wgid % NXCD, off = wgid / NXCD; wgid = (xcd < r ? xcd * (q + 1) : r * (q + 1) + (xcd - r) * q) + off; }
        const int nig = WGM * nN, gid = wgid / nig, fm = gid * WGM, gsz = (nM - fm) < WGM ? (nM - fm) : WGM;
        u.pm = fm + ((wgid % nig) % gsz); u.pn = (wgid % nig) / gsz; return true;
    }
    __device__ __forceinline__ void a_ready(const Unit&) const {}
    __device__ __forceinline__ void done(const Unit&) const {}
};

typedef __bf16 bf16x2_cv __attribute__((ext_vector_type(2)));
typedef float f32x2_cv __attribute__((ext_vector_type(2)));
__device__ __forceinline__ unsigned cvt_pk_bf16(float lo, float hi) { const f32x2_cv f = {lo, hi}; const bf16x2_cv b = __builtin_convertvector(f, bf16x2_cv); return __builtin_bit_cast(unsigned, b); }
typedef float f32x2 __attribute__((ext_vector_type(2)));
__device__ __forceinline__ f32x2 gelu_pk(f32x2 v) {
    const f32x2 av = __builtin_elementwise_abs(v), d = av * 0.2316418882f + 1.0f;
    f32x2 t; t.x = __builtin_amdgcn_rcpf(d.x); t.y = __builtin_amdgcn_rcpf(d.y);
    f32x2 q = t * 0.5307027145f + (-0.7265760135f); q = q * t + 0.7107068705f; q = q * t + (-0.142248368f); q = q * t + 0.127414796f; q = q * t;
    const f32x2 s = (v * v) * (-0.72134752044f);
    f32x2 e; e.x = __builtin_amdgcn_exp2f(s.x); e.y = __builtin_amdgcn_exp2f(s.y);
    const f32x2 m = v * (q * e), r = v - m;
    f32x2 o; o.x = v.x < 0.f ? m.x : r.x; o.y = v.y < 0.f ? m.y : r.y; return o;
}

constexpr int PW = 2816;
struct EpiInProj {
    static constexpr bool PERM = true, AFTER_DRAIN = false;
    bf16_t* P;
    __device__ __forceinline__ void operator()(const f32x4 (&acc)[2][2][4][2], const Unit& u, int wr, int wc, int fr, int fq) const {
        const int row0 = u.pm * BM + wr * 64 + fr; const int pn = u.pn;
        if (pn >= 2 && pn < 8) {
            const int col0 = 512 + (pn - 2) * 128 + wc * 32 + 8 * fq;
#pragma unroll
            for (int ai = 0; ai < 2; ++ai)
#pragma unroll
                for (int m = 0; m < 4; ++m) { bf16_t* rowp = P + (size_t)(row0 + ai * HALF + m * 16) * PW + col0;
                    float o[8];
#pragma unroll
                    for (int n = 0; n < 2; ++n)
#pragma unroll
                        for (int j = 0; j < 4; ++j) { const float v = acc[ai][0][m][n][j], g = acc[ai][1][m][n][j];
                            o[n * 4 + j] = v * __builtin_amdgcn_rcpf(1.0f + __builtin_amdgcn_exp2f(g * -1.4426950408889634f)); }
                    u32x4 w; w.x = cvt_pk_bf16(o[0], o[1]); w.y = cvt_pk_bf16(o[2], o[3]); w.z = cvt_pk_bf16(o[4], o[5]); w.w = cvt_pk_bf16(o[6], o[7]);
                    *(u32x4*)rowp = w; }
        } else {
            const int colt = pn < 2 ? pn * 256 : 1280 + (pn - 8) * 256; const bool act = pn >= 8;
            const int col0 = colt + wc * 32 + 8 * fq;
#pragma unroll
            for (int ai = 0; ai < 2; ++ai)
#pragma unroll
                for (int m = 0; m < 4; ++m) { bf16_t* rowp = P + (size_t)(row0 + ai * HALF + m * 16) * PW + col0;
#pragma unroll
                    for (int bj = 0; bj < 2; ++bj) { f32x4 v0 = acc[ai][bj][m][0], v1 = acc[ai][bj][m][1];
                        if (act) { f32x2 a = gelu_pk((f32x2){v0[0], v0[1]}), b = gelu_pk((f32x2){v0[2], v0[3]}), c = gelu_pk((f32x2){v1[0], v1[1]}), d = gelu_pk((f32x2){v1[2], v1[3]});
                            v0 = (f32x4){a.x, a.y, b.x, b.y}; v1 = (f32x4){c.x, c.y, d.x, d.y}; }
                        u32x4 w; w.x = cvt_pk_bf16(v0[0], v0[1]); w.y = cvt_pk_bf16(v0[2], v0[3]); w.z = cvt_pk_bf16(v1[0], v1[1]); w.w = cvt_pk_bf16(v1[2], v1[3]);
                        *(u32x4*)(rowp + bj * HALF) = w; } }
        }
    }
};
struct EpiResid {
    static constexpr bool PERM = false, AFTER_DRAIN = false;
    const float* xin; float* xout; const float* gate; float alpha;
    __device__ __forceinline__ void operator()(const f32x4 (&acc)[2][2][4][2], const Unit& u, int wr, int wc, int fr, int fq) const {
        const int row0 = u.pm * BM + wr * 64 + fr, col0 = u.pn * BM + wc * 32 + 4 * fq;
        const float* gp = gate + (size_t)(u.pm >> 3) * 12288 + col0;
        f32x4 gv[2][2];
#pragma unroll
        for (int bj = 0; bj < 2; ++bj)
#pragma unroll
            for (int n = 0; n < 2; ++n) gv[bj][n] = *(const f32x4*)(gp + bj * HALF + n * 16);
#pragma unroll
        for (int ai = 0; ai < 2; ++ai)
#pragma unroll
            for (int m = 0; m < 4; ++m) { const size_t off = (size_t)(row0 + ai * HALF + m * 16) * 2048 + col0;
#pragma unroll
                for (int bj = 0; bj < 2; ++bj)
#pragma unroll
                    for (int n = 0; n < 2; ++n) { const f32x4 xv = *(const f32x4*)(xin + off + bj * HALF + n * 16);
                        *(f32x4*)(xout + off + bj * HALF + n * 16) = xv * alpha + gv[bj][n] * acc[ai][bj][m][n]; }
                asm volatile("" ::: "memory"); }
    }
};
struct EpiRelu2 {
    static constexpr bool PERM = true, AFTER_DRAIN = false;
    bf16_t* O;
    __device__ __forceinline__ void operator()(const f32x4 (&acc)[2][2][4][2], const Unit& u, int wr, int wc, int fr, int fq) const {
        const int row0 = u.pm * BM + wr * 64 + fr, col0 = u.pn * BM + wc * 32 + 8 * fq;
#pragma unroll
        for (int ai = 0; ai < 2; ++ai)
#pragma unroll
            for (int m = 0; m < 4; ++m) { bf16_t* rowp = O + (size_t)(row0 + ai * HALF + m * 16) * 8192 + col0;
#pragma unroll
                for (int bj = 0; bj < 2; ++bj) { f32x4 v0 = acc[ai][bj][m][0], v1 = acc[ai][bj][m][1];
#pragma unroll
                    for (int j = 0; j < 4; ++j) { const float a = fmaxf(v0[j], 0.f), b = fmaxf(v1[j], 0.f); v0[j] = a * a; v1[j] = b * b; }
                    u32x4 w; w.x = cvt_pk_bf16(v0[0], v0[1]); w.y = cvt_pk_bf16(v0[2], v0[3]); w.z = cvt_pk_bf16(v1[0], v1[1]); w.w = cvt_pk_bf16(v1[2], v1[3]);
                    *(u32x4*)(rowp + bj * HALF) = w; } }
    }
};

template <class Epi, class Sched, bool ALIGN_EPI = false, bool SP2 = false>
__device__ __forceinline__ void gemm_phase(PG8_LAS unsigned char* lds, const Gemm g, const Sched& S, const Epi& E) {
    int tid_ = threadIdx.x; asm volatile("" : "+v"(tid_)); const int tid = tid_, wid = __builtin_amdgcn_readfirstlane(tid >> 6), lane = tid & 63, wr = wid >> 2, wc = wid & 3, fr = lane & 15, fq = lane >> 4;
    const int K = g.K, nt = K / BK;
    unsigned voffA[2], voffB[2];
#pragma unroll
    for (int i = 0; i < 2; ++i) { int R, C; stage_rc(tid * 16 + i * 8192, R, C); const int Rb = Epi::PERM ? ((R & ~31) + perm32(R & 31)) : R;
        voffA[i] = (unsigned)(R * K + C) * 2u; voffB[i] = (unsigned)(Rb * K + C) * 2u; }
    const size_t kstep = (size_t)(BK * 2);
    const size_t hstep = (size_t)HALF * K * 2;
    const size_t tstep = 2 * hstep;
    const unsigned ldsw = (unsigned)wid * 1024u;
    const int aoff = lds_byte(wr * 64 + fr, fq * 8), boff = lds_byte(wc * 32 + fr, fq * 8);
#define PG8_SA(b, h) (((b) * 2 + (h)) * HTB)
#define PG8_SB(b, h) ((4 + (b) * 2 + (h)) * HTB)
#define PG8_STAGE(bufoff, gbase, voff) do { _Pragma("unroll") for (int _i = 0; _i < 2; ++_i) \
        __builtin_amdgcn_global_load_lds((const unsigned*)((const char*)(gbase) + (voff)[_i]), (PG8_LAS unsigned*)(lds + (bufoff) + ldsw + _i * 8192), 16, 0, 0); } while (0)
#define PG8_LDA(dst, b, h) do { _Pragma("unroll") for (int m = 0; m < 4; ++m) _Pragma("unroll") for (int k = 0; k < 2; ++k) dst[m][k] = *(const PG8_LAS bf16x8*)(lds + PG8_SA(b, h) + aoff + m * 2048 + k * 1024); } while (0)
#define PG8_LDB(dst, b, h) do { _Pragma("unroll") for (int n = 0; n < 2; ++n) _Pragma("unroll") for (int k = 0; k < 2; ++k) dst[n][k] = *(const PG8_LAS bf16x8*)(lds + PG8_SB(b, h) + boff + n * 2048 + k * 1024); } while (0)
#define PG8_MMA(ai, bj, At, Bt) do { __builtin_amdgcn_s_setprio(1); _Pragma("unroll") for (int m = 0; m < 4; ++m) _Pragma("unroll") for (int n = 0; n < 2; ++n) _Pragma("unroll") for (int k = 0; k < 2; ++k) \
        acc[ai][bj][m][n] = __builtin_amdgcn_mfma_f32_16x16x32_bf16(Bt[n][k], At[m][k], acc[ai][bj][m][n], 0, 0, 0); __builtin_amdgcn_s_setprio(0); } while (0)
#define PG8_WAIT_V(n) asm volatile("s_waitcnt vmcnt(" #n ")" ::: "memory")
#define PG8_WAIT_L(n) asm volatile("s_waitcnt lgkmcnt(" #n ")" ::: "memory")
#define PG8_BAR __builtin_amdgcn_s_barrier()
#define PG8_SCHED __builtin_amdgcn_sched_barrier(0)
    Unit cur, nxt; int ui = 0;
    if (!S.next(0, cur)) return;
    f32x4 acc[2][2][4][2];
#pragma unroll
    for (int a = 0; a < 2; ++a)
#pragma unroll
        for (int b = 0; b < 2; ++b)
#pragma unroll
            for (int m = 0; m < 4; ++m)
#pragma unroll
                for (int n = 0; n < 2; ++n) acc[a][b][m][n] = (f32x4){0.f, 0.f, 0.f, 0.f};
    bf16x8 At[4][2], B0[2][2], B1[2][2];
    const char* cA = (const char*)g.A + (size_t)cur.pm * tstep; const char* cB = (const char*)g.Bt + (size_t)cur.pn * tstep;
    S.a_ready(cur);
    if constexpr (SP2) {
        PG8_STAGE(PG8_SB(0, 0), cB, voffB); PG8_STAGE(PG8_SB(0, 1), cB + hstep, voffB); PG8_STAGE(PG8_SA(0, 0), cA, voffA); PG8_STAGE(PG8_SA(0, 1), cA + hstep, voffA);
        if (wr == 1) PG8_BAR;
        PG8_WAIT_V(2); PG8_BAR;
        PG8_STAGE(PG8_SB(1, 0), cB + kstep, voffB); PG8_STAGE(PG8_SA(1, 0), cA + kstep, voffA); PG8_STAGE(PG8_SB(1, 1), cB + hstep + kstep, voffB);
        PG8_WAIT_V(6); PG8_BAR;
    } else {
        PG8_STAGE(PG8_SB(0, 0), cB, voffB); PG8_STAGE(PG8_SA(0, 0), cA, voffA); PG8_STAGE(PG8_SB(0, 1), cB + hstep, voffB); PG8_STAGE(PG8_SA(0, 1), cA + hstep, voffA);
        if (wr == 1) PG8_BAR;
        PG8_WAIT_V(4); PG8_BAR;
        PG8_STAGE(PG8_SB(1, 0), cB + kstep, voffB); PG8_STAGE(PG8_SA(1, 0), cA + kstep, voffA); PG8_STAGE(PG8_SB(1, 1), cB + hstep + kstep, voffB);
        PG8_WAIT_V(6); PG8_BAR;
    }
    for (;;) {
        const bool has_next = S.next(ui + 1, nxt);
        const char* nA = has_next ? (const char*)g.A + (size_t)nxt.pm * tstep : cA; const char* nB = has_next ? (const char*)g.Bt + (size_t)nxt.pn * tstep : cB;
        for (int t = 0; t < nt; t += 2) {
            const bool last = (t == nt - 2);
            const char* a1 = cA + (size_t)(t + 1) * kstep;
            const char* a2 = last ? nA : cA + (size_t)(t + 2) * kstep; const char* b2 = last ? nB : cB + (size_t)(t + 2) * kstep;
            const char* a3 = a2 + kstep; const char* b3 = b2 + kstep;
            if (last && has_next) S.a_ready(nxt);
            if constexpr (SP2) {
            PG8_LDB(B0, 0, 0); PG8_LDB(B1, 0, 1); PG8_SCHED; PG8_LDA(At, 0, 0); PG8_STAGE(PG8_SA(1, 1), a1 + hstep, voffA);
            PG8_WAIT_V(8); PG8_WAIT_L(0); PG8_BAR; PG8_MMA(0, 0, At, B0); PG8_MMA(0, 1, At, B1); PG8_BAR; PG8_SCHED;
            PG8_LDA(At, 0, 1); PG8_STAGE(PG8_SB(0, 0), b2, voffB); PG8_STAGE(PG8_SB(0, 1), b2 + hstep, voffB); PG8_STAGE(PG8_SA(0, 0), a2, voffA);
            PG8_WAIT_V(8); PG8_WAIT_L(0); PG8_BAR; PG8_MMA(1, 0, At, B0); PG8_MMA(1, 1, At, B1); PG8_BAR; PG8_SCHED;
            PG8_LDB(B0, 1, 0); PG8_LDB(B1, 1, 1); PG8_SCHED; PG8_LDA(At, 1, 0); PG8_STAGE(PG8_SA(0, 1), a2 + hstep, voffA);
            PG8_WAIT_V(8); PG8_WAIT_L(0); PG8_BAR; PG8_MMA(0, 0, At, B0); PG8_MMA(0, 1, At, B1); PG8_BAR; PG8_SCHED;
            PG8_LDA(At, 1, 1); PG8_STAGE(PG8_SB(1, 0), b3, voffB); PG8_STAGE(PG8_SB(1, 1), b3 + hstep, voffB); PG8_STAGE(PG8_SA(1, 0), a3, voffA);
            PG8_WAIT_V(8); PG8_WAIT_L(0); PG8_BAR; PG8_MMA(1, 0, At, B0); PG8_MMA(1, 1, At, B1); PG8_BAR; PG8_SCHED;
            } else {
            PG8_LDB(B0, 0, 0); PG8_SCHED; PG8_LDA(At, 0, 0); PG8_STAGE(PG8_SA(1, 1), a1 + hstep, voffA);
            PG8_WAIT_L(8); PG8_BAR; PG8_WAIT_L(0); PG8_MMA(0, 0, At, B0); PG8_BAR; PG8_SCHED;
            PG8_LDB(B1, 0, 1); PG8_STAGE(PG8_SB(0, 0), b2, voffB);
            PG8_BAR; PG8_WAIT_L(0); PG8_MMA(0, 1, At, B1); PG8_BAR;
            PG8_LDA(At, 0, 1); PG8_STAGE(PG8_SA(0, 0), a2, voffA);
            PG8_BAR; PG8_WAIT_L(0); PG8_MMA(1, 0, At, B0); PG8_BAR; PG8_SCHED;
            PG8_STAGE(PG8_SB(0, 1), b2 + hstep, voffB);
            PG8_WAIT_V(6); PG8_BAR; PG8_MMA(1, 1, At, B1); PG8_BAR;
            PG8_LDB(B0, 1, 0); PG8_SCHED; PG8_LDA(At, 1, 0); PG8_STAGE(PG8_SA(0, 1), a2 + hstep, voffA);
            PG8_WAIT_L(8); PG8_BAR; PG8_WAIT_L(0); PG8_MMA(0, 0, At, B0); PG8_BAR; PG8_SCHED;
            PG8_LDB(B1, 1, 1); PG8_STAGE(PG8_SB(1, 0), b3, voffB);
            PG8_BAR; PG8_WAIT_L(0); PG8_MMA(0, 1, At, B1); PG8_BAR;
            PG8_LDA(At, 1, 1); PG8_STAGE(PG8_SA(1, 0), a3, voffA);
            PG8_BAR; PG8_WAIT_L(0); PG8_MMA(1, 0, At, B0); PG8_BAR; PG8_SCHED;
            PG8_STAGE(PG8_SB(1, 1), b3 + hstep, voffB);
            PG8_WAIT_V(6); PG8_BAR; PG8_MMA(1, 1, At, B1); PG8_BAR;
            }
        }
        if constexpr (ALIGN_EPI) { if (wr == 0) PG8_BAR; }
        if constexpr (!Epi::AFTER_DRAIN) { E(acc, cur, wr, wc, fr, fq); S.done(cur); }
        if (!has_next) break;
#pragma unroll
        for (int a = 0; a < 2; ++a)
#pragma unroll
            for (int b = 0; b < 2; ++b)
#pragma unroll
                for (int m = 0; m < 4; ++m)
#pragma unroll
                    for (int n = 0; n < 2; ++n) acc[a][b][m][n] = (f32x4){0.f, 0.f, 0.f, 0.f};
        cur = nxt; cA = nA; cB = nB; ++ui;
        if constexpr (ALIGN_EPI) { if (wr == 1) PG8_BAR; }
    }
    PG8_WAIT_V(0);
    if constexpr (!ALIGN_EPI) { if (wr == 0) PG8_BAR; }
    PG8_BAR;
    if constexpr (Epi::AFTER_DRAIN) { E.fused(acc, cur, wr, wc, fr, fq, lds, wid, lane); S.done(cur); }
#undef PG8_SA
#undef PG8_SB
#undef PG8_STAGE
#undef PG8_LDA
#undef PG8_LDB
#undef PG8_MMA
#undef PG8_WAIT_V
#undef PG8_WAIT_L
#undef PG8_BAR
#undef PG8_SCHED
}
}

#define LAS __attribute__((address_space(3)))
typedef unsigned short bf16;
typedef unsigned v4u __attribute__((ext_vector_type(4)));
typedef unsigned v2u __attribute__((ext_vector_type(2)));
typedef float f32x4 __attribute__((ext_vector_type(4)));
typedef float f32x2 __attribute__((ext_vector_type(2)));
typedef short bf16x8 __attribute__((ext_vector_type(8)));
constexpr int NB = 16, SEQ = 2048, D = 2048, M = NB * SEQ, DFF = 8192, NIN = 3584, PW = pg8::PW, NMOD = 12288;
constexpr float LN_EPS = 1e-5f, ALPHA = 1.4142135623730951f;
constexpr int NWAVES = 8, NTHR = 512;
constexpr int LDS_BYTES = 147456;
constexpr size_t MiB = 1u << 20;
constexpr size_t WS_MOD = 0;
constexpr size_t WS_WPOOL = 3 * MiB / 2;
constexpr size_t WS_WSGU = 2 * MiB;
constexpr size_t WS_WIN = 4 * MiB, WS_WOUT = 32 * MiB, WS_WFF1 = 48 * MiB, WS_WFF2 = 112 * MiB;
constexpr size_t WS_H = 176 * MiB;
constexpr size_t WS_BIG = 304 * MiB;
constexpr size_t WS_P = WS_BIG, WS_Y = WS_BIG + 224 * MiB, WS_END = WS_BIG + 512 * MiB;

#define LDS_WAIT() asm volatile("s_waitcnt lgkmcnt(0)" ::: "memory")
__device__ __forceinline__ unsigned pk2(float lo, float hi) { return pg8::cvt_pk_bf16(lo, hi); }
__device__ __forceinline__ float bflo(unsigned w) { return __uint_as_float(w << 16); }
__device__ __forceinline__ float bfhi(unsigned w) { return __uint_as_float(w & 0xffff0000u); }
__device__ __forceinline__ float wave_sum(float v) {
#pragma unroll
    for (int o = 1; o < 64; o <<= 1) v += __shfl_xor(v, o);
    return v;
}

struct Args { const float* in[22]; float* out; unsigned char* ws; int ph_lo, ph_hi; };

__device__ __forceinline__ void transpose_item(const float* W, int ldw, int K, int srccol0, bf16* WT, int dstrow0, int k0, LAS float* scr, int lane) {
#pragma unroll 8
    for (int i = 0; i < 32; ++i) { const int kk = 2 * i + (lane >> 5); scr[kk * 33 + (lane & 31)] = W[(size_t)(k0 + kk) * ldw + srccol0 + (lane & 31)]; }
    LDS_WAIT();
    const int c = lane & 7;
#pragma unroll
    for (int j = 0; j < 4; ++j) { const int n = (lane >> 3) + 8 * j; const LAS float* s = scr + (8 * c) * 33 + n;
        v4u o; o.x = pk2(s[0 * 33], s[1 * 33]); o.y = pk2(s[2 * 33], s[3 * 33]); o.z = pk2(s[4 * 33], s[5 * 33]); o.w = pk2(s[6 * 33], s[7 * 33]);
        *(v4u*)(WT + (size_t)(dstrow0 + n) * K + k0 + 8 * c) = o; }
    LDS_WAIT();
}
__device__ __forceinline__ void prologue_phase(LAS unsigned char* lds, const __attribute__((address_space(4))) Args* ap, int tid, int wave, int lane) {
    unsigned char* ws = ap->ws;
    {
        LAS float* CA = (LAS float*)lds;
        const float* c = ap->in[1]; const float* wm = ap->in[2]; const float* bm = ap->in[3]; float* mod = (float*)(ws + WS_MOD);
        for (int it = blockIdx.x; it < 192; it += gridDim.x) {
            for (int i = tid; i < NB * D; i += NTHR) { const int b = i >> 11, k = i & 2047; const float v = c[i]; CA[k * 16 + b] = v * __builtin_amdgcn_rcpf(1.0f + __builtin_amdgcn_exp2f(v * -1.4426950408889634f)); }
            __syncthreads();
            const int gc0 = it * 128, l = gc0 / NMOD, j0 = gc0 % NMOD, ks = tid >> 5, cl = tid & 31;
            const float* wp = wm + (size_t)l * D * NMOD + (size_t)(ks * 128) * NMOD + j0 + cl * 4;
            f32x4 acc[16];
#pragma unroll
            for (int b = 0; b < 16; ++b) acc[b] = (f32x4){0.f, 0.f, 0.f, 0.f};
#pragma unroll 4
            for (int k = 0; k < 128; ++k) {
                const f32x4 w = *(const f32x4*)(wp + (size_t)k * NMOD);
                const LAS f32x4* cp = (const LAS f32x4*)(CA + (ks * 128 + k) * 16);
#pragma unroll
                for (int q = 0; q < 4; ++q) { const f32x4 cv = cp[q];
#pragma unroll
                    for (int e = 0; e < 4; ++e) acc[q * 4 + e] += w * cv[e]; }
            }
            __syncthreads();
#pragma unroll
            for (int b = 0; b < 16; ++b) *(LAS f32x4*)(CA + (ks * 16 + b) * 128 + cl * 4) = acc[b];
            __syncthreads();
            for (int o = tid; o < 16 * 128; o += NTHR) { const int b = o >> 7, cc = o & 127; float s = bm[(size_t)l * NMOD + j0 + cc];
#pragma unroll
                for (int q = 0; q < 16; ++q) s += CA[(q * 16 + b) * 128 + cc];
                mod[((size_t)l * NB + b) * NMOD + j0 + cc] = s; }
            __syncthreads();
        }
    }
    {
        bf16* wpl = (bf16*)(ws + WS_WPOOL); const float* wp = ap->in[5]; const float* ls = ap->in[6];
        for (int i = blockIdx.x * NTHR + tid; i < 2 * 4 * 128 * 128; i += gridDim.x * NTHR) { const int c = i & 127, d = (i >> 7) & 127, lg = i >> 14;
            wpl[i] = (bf16)(pk2(wp[((size_t)lg * 128 + c) * 128 + d] * ls[lg * 128 + d], 0.f) & 0xffffu); }
        bf16* wsg = (bf16*)(ws + WS_WSGU); const float* wsf = ap->in[11];
        for (int i = blockIdx.x * NTHR + tid; i < 2 * 6 * 128 * 128; i += gridDim.x * NTHR) { const int s = i & 127, t = (i >> 7) & 127;
            wsg[i] = (bf16)(pk2(s <= t ? wsf[i] : 0.f, 0.f) & 0xffffu); }
    }
    {
        LAS float* scr = (LAS float*)(lds + wave * 16384);
        const int gw = blockIdx.x * NWAVES + wave, NGW = gridDim.x * NWAVES;
        constexpr int I_IN = 32 * 112, I_OUT = 32 * 64, I_F1 = 32 * 256, I_F2 = 128 * 64, I_L = I_IN + I_OUT + I_F1 + I_F2;
        for (int it = gw; it < 2 * I_L; it += NGW) {
            const int l = it / I_L; int r = it % I_L;
            if (r < I_IN) { const int kb = r / 112, n0 = (r % 112) * 32, tile = n0 >> 8, within = n0 & 255;
                const int src = (tile >= 2 && tile < 8) ? 512 + (within >> 7) * 768 + (tile - 2) * 128 + (within & 127) : n0;
                transpose_item(ap->in[4] + (size_t)l * D * NIN, NIN, D, src, (bf16*)(ws + WS_WIN) + (size_t)l * NIN * D, n0, kb * 64, scr, lane); continue; }
            r -= I_IN;
            if (r < I_OUT) { transpose_item(ap->in[15] + (size_t)l * D * D, D, D, (r % 64) * 32, (bf16*)(ws + WS_WOUT) + (size_t)l * D * D, (r % 64) * 32, (r / 64) * 64, scr, lane); continue; }
            r -= I_OUT;
            if (r < I_F1) { transpose_item(ap->in[18] + (size_t)l * D * DFF, DFF, D, (r % 256) * 32, (bf16*)(ws + WS_WFF1) + (size_t)l * DFF * D, (r % 256) * 32, (r / 256) * 64, scr, lane); continue; }
            r -= I_F1;
            transpose_item(ap->in[19] + (size_t)l * DFF * D, D, DFF, (r % 64) * 32, (bf16*)(ws + WS_WFF2) + (size_t)l * D * DFF, (r % 64) * 32, (r / 64) * 64, scr, lane);
        }
    }
}

template <bool LN, bool WX, bool WH>
__device__ __forceinline__ void lnmod_phase(const float* src, float* xout, bf16* hout, const float* g, const float* bt, const float* shift, const float* scale, int wave, int lane) {
    const int gw = blockIdx.x * NWAVES + wave, NGW = gridDim.x * NWAVES;
    for (int m = gw; m < M; m += NGW) {
        const f32x4* xr = (const f32x4*)(src + (size_t)m * D) + lane;
        f32x4 v[8];
#pragma unroll
        for (int j = 0; j < 8; ++j) v[j] = xr[64 * j];
        if (LN) {
            float s = 0.f;
#pragma unroll
            for (int j = 0; j < 8; ++j) s += (v[j][0] + v[j][1]) + (v[j][2] + v[j][3]);
            const float mean = wave_sum(s) * (1.f / D); float q = 0.f;
#pragma unroll
            for (int j = 0; j < 8; ++j) { v[j] = v[j] - mean; q += (v[j][0] * v[j][0] + v[j][1] * v[j][1]) + (v[j][2] * v[j][2] + v[j][3] * v[j][3]); }
            const float rstd = 1.0f / sqrtf(wave_sum(q) * (1.f / D) + LN_EPS);
#pragma unroll
            for (int j = 0; j < 8; ++j) { const f32x4 gg = *((const f32x4*)g + 64 * j + lane), bb = *((const f32x4*)bt + 64 * j + lane); v[j] = v[j] * rstd * gg + bb; }
        }
        if (WX) { f32x4* xo = (f32x4*)(xout + (size_t)m * D) + lane;
#pragma unroll
            for (int j = 0; j < 8; ++j) xo[64 * j] = v[j]; }
        if (WH) { const int b = m >> 11; const f32x4* sh = (const f32x4*)(shift + (size_t)b * NMOD) + lane; const f32x4* sc = (const f32x4*)(scale + (size_t)b * NMOD) + lane;
            v2u* ho = (v2u*)(hout + (size_t)m * D) + lane;
#pragma unroll
            for (int j = 0; j < 8; ++j) { const f32x4 h = v[j] * (sc[64 * j] + 1.0f) + sh[64 * j]; v2u w; w.x = pk2(h[0], h[1]); w.y = pk2(h[2], h[3]); ho[64 * j] = w; } }
    }
}

struct MixW { const bf16* wpoolT; const bf16* wsgu; const float* bsgu; const float* lsg; const float* lsb; const float* cw; const float* cb; const float* lcg; const float* lcb; };

__device__ __forceinline__ void sgu_unit(LAS unsigned char* lds, const bf16* P, bf16* Y, const MixW& w, int r0, int tid, int wave, int lane) {
    LAS float* ST = (LAS float*)lds;
    LAS bf16* VT = (LAS bf16*)(lds + 1024);
    for (int i = 0; i < 16; ++i) { const int t = wave * 16 + i; const bf16* vr = P + (size_t)(r0 + t) * PW + 2048;
        float x[12];
#pragma unroll
        for (int k = 0; k < 3; ++k) { const v2u q = *(const v2u*)(vr + k * 256 + lane * 4); x[4 * k] = bflo(q.x); x[4 * k + 1] = bfhi(q.x); x[4 * k + 2] = bflo(q.y); x[4 * k + 3] = bfhi(q.y); }
        float s = 0.f;
#pragma unroll
        for (int k = 0; k < 12; ++k) s += x[k];
        const float mean = wave_sum(s) * (1.f / 768.f); float qq = 0.f;
#pragma unroll
        for (int k = 0; k < 12; ++k) { const float dlt = x[k] - mean; qq += dlt * dlt; }
        const float rstd = 1.0f / sqrtf(wave_sum(qq) * (1.f / 768.f) + LN_EPS);
        if (lane == 0) { ST[2 * t] = mean; ST[2 * t + 1] = rstd; } }
    __syncthreads();
    for (int h = 0; h < 6; ++h) {
        { const int s = tid & 127, dg = tid >> 7; const bf16* vr = P + (size_t)(r0 + s) * PW + 2048 + h * 128 + dg * 32; const float mean = ST[2 * s], rstd = ST[2 * s + 1];
          const float* gp = w.lsg + h * 128 + dg * 32; const float* bp = w.lsb + h * 128 + dg * 32;
#pragma unroll
          for (int q = 0; q < 4; ++q) { const v4u xw = *(const v4u*)(vr + q * 8); const unsigned ww[4] = {xw.x, xw.y, xw.z, xw.w};
#pragma unroll
              for (int e = 0; e < 4; ++e) { const int d = dg * 32 + q * 8 + 2 * e;
                  const float y0 = (bflo(ww[e]) - mean) * rstd * gp[q * 8 + 2 * e] + bp[q * 8 + 2 * e], y1 = (bfhi(ww[e]) - mean) * rstd * gp[q * 8 + 2 * e + 1] + bp[q * 8 + 2 * e + 1];
                  const unsigned pkd = pk2(y0, y1); VT[d * 136 + s] = (bf16)(pkd & 0xffffu); VT[(d + 1) * 136 + s] = (bf16)(pkd >> 16); } } }
        __syncthreads();
        const int nkb = (wave >> 1) + 1;
        f32x4 acc[8];
#pragma unroll
        for (int db = 0; db < 8; ++db) acc[db] = (f32x4){0.f, 0.f, 0.f, 0.f};
        for (int kb = 0; kb < nkb; ++kb) {
            const bf16x8 yf = *(const bf16x8*)(w.wsgu + ((size_t)(h * 128 + wave * 16 + (lane & 15))) * 128 + kb * 32 + (lane >> 4) * 8);
#pragma unroll
            for (int db = 0; db < 8; ++db) { const bf16x8 xf = *(const LAS bf16x8*)(VT + (db * 16 + (lane & 15)) * 136 + kb * 32 + (lane >> 4) * 8);
                acc[db] = __builtin_amdgcn_mfma_f32_16x16x32_bf16(xf, yf, acc[db], 0, 0, 0); }
        }
        { const int t = wave * 16 + (lane & 15); const float bias = w.bsgu[h * 128 + t];
          const bf16* up = P + (size_t)(r0 + t) * PW + 1280 + h * 128 + (lane >> 4) * 4; bf16* yp = Y + (size_t)(r0 + t) * D + 1280 + h * 128 + (lane >> 4) * 4;
#pragma unroll
          for (int db = 0; db < 8; ++db) { const v2u uw = *(const v2u*)(up + db * 16);
              v2u o; o.x = pk2(bflo(uw.x) * (acc[db][0] + bias), bfhi(uw.x) * (acc[db][1] + bias)); o.y = pk2(bflo(uw.y) * (acc[db][2] + bias), bfhi(uw.y) * (acc[db][3] + bias));
              *(v2u*)(yp + db * 16) = o; } }
        __syncthreads();
    }
}

__device__ __forceinline__ void pool_unit(LAS unsigned char* lds, const bf16* P, bf16* Y, const MixW& w, int r0, int tid, int wave, int lane) {
    LAS bf16* AT = (LAS bf16*)lds;
    LAS bf16* PL = (LAS bf16*)(lds + 36864);
    const int pos0 = r0 & (SEQ - 1);
    for (int g = 0; g < 4; ++g) {
        for (int i = tid; i < 143 * 16; i += NTHR) { const int row = i >> 4, vec = i & 15, tt = row - 15; v4u q = (v4u){0u, 0u, 0u, 0u};
            if (pos0 + tt >= 0) q = *(const v4u*)(P + (size_t)(r0 + tt) * PW + g * 128 + vec * 8);
            *(LAS v4u*)(AT + row * 128 + vec * 8) = q; }
        __syncthreads();
        const int win = 2 << g;
#pragma unroll
        for (int pass = 0; pass < 4; ++pass) { const int t = pass * 32 + (tid >> 4), vec = tid & 15;
            float sacc[8], self[8];
#pragma unroll
            for (int e = 0; e < 8; ++e) sacc[e] = 0.f;
            for (int j = 0; j < win; ++j) { const v4u q = *(const LAS v4u*)(AT + (15 + t - j) * 128 + vec * 8); const unsigned ww[4] = {q.x, q.y, q.z, q.w};
#pragma unroll
                for (int e = 0; e < 4; ++e) { const float lo = bflo(ww[e]), hi = bfhi(ww[e]); sacc[2 * e] += lo; sacc[2 * e + 1] += hi; if (j == 0) { self[2 * e] = lo; self[2 * e + 1] = hi; } } }
            const int cnt = min(pos0 + t + 1, win); const float inv = 1.0f / (float)cnt;
            v4u o; o.x = pk2(sacc[0] * inv - self[0], sacc[1] * inv - self[1]); o.y = pk2(sacc[2] * inv - self[2], sacc[3] * inv - self[3]);
            o.z = pk2(sacc[4] * inv - self[4], sacc[5] * inv - self[5]); o.w = pk2(sacc[6] * inv - self[6], sacc[7] * inv - self[7]);
            *(LAS v4u*)(PL + t * 136 + vec * 8) = o; }
        __syncthreads();
        f32x4 acc[8];
#pragma unroll
        for (int db = 0; db < 8; ++db) acc[db] = (f32x4){0.f, 0.f, 0.f, 0.f};
#pragma unroll
        for (int kb = 0; kb < 4; ++kb) {
            const bf16x8 yf = *(const LAS bf16x8*)(PL + (wave * 16 + (lane & 15)) * 136 + kb * 32 + (lane >> 4) * 8);
#pragma unroll
            for (int db = 0; db < 8; ++db) { const bf16x8 xf = *(const bf16x8*)(w.wpoolT + ((size_t)(g * 128 + db * 16 + (lane & 15))) * 128 + kb * 32 + (lane >> 4) * 8);
                acc[db] = __builtin_amdgcn_mfma_f32_16x16x32_bf16(xf, yf, acc[db], 0, 0, 0); }
        }
        { const int t = wave * 16 + (lane & 15); bf16* yp = Y + (size_t)(r0 + t) * D + g * 128 + (lane >> 4) * 4;
#pragma unroll
          for (int db = 0; db < 8; ++db) { v2u o; o.x = pk2(acc[db][0], acc[db][1]); o.y = pk2(acc[db][2], acc[db][3]); *(v2u*)(yp + db * 16) = o; } }
        __syncthreads();
    }
}

__device__ __forceinline__ void conv_unit(LAS unsigned char* lds, const bf16* P, bf16* Y, const MixW& w, int c0, int tid, int wave, int lane) {
    LAS unsigned* CO = (LAS unsigned*)lds;
    LAS unsigned* HG = (LAS unsigned*)(lds + 98304);
    const int pos0 = c0 & (SEQ - 1);
    float s1[2][4], s2[2][4];
#pragma unroll
    for (int i = 0; i < 2; ++i)
#pragma unroll
        for (int tt = 0; tt < 4; ++tt) { s1[i][tt] = 0.f; s2[i][tt] = 0.f; }
    for (int slab = 0; slab < 6; ++slab) {
        for (int i = tid; i < 94 * 16; i += NTHR) { const int row = i >> 4, vec = i & 15, tt = row - 30; v4u q = (v4u){0u, 0u, 0u, 0u};
            if (pos0 + tt >= 0) q = *(const v4u*)(P + (size_t)(c0 + tt) * PW + 512 + slab * 128 + vec * 8);
            *(LAS v4u*)(HG + row * 64 + vec * 4) = q; }
        float w0[31], w1[31];
#pragma unroll
        for (int j = 0; j < 31; ++j) { const f32x2 ww = *(const f32x2*)(w.cw + j * 768 + slab * 128 + 2 * lane); w0[j] = ww.x; w1[j] = ww.y; }
        const f32x2 cbv = *(const f32x2*)(w.cb + slab * 128 + 2 * lane);
        __syncthreads();
#pragma unroll
        for (int i = 0; i < 2; ++i) { const int tg = wave + 8 * i;
            float o0[4], o1[4];
#pragma unroll
            for (int tt = 0; tt < 4; ++tt) { o0[tt] = cbv.x; o1[tt] = cbv.y; }
#pragma unroll
            for (int r = 0; r < 34; ++r) { const unsigned xw = HG[(4 * tg + r) * 64 + lane]; const float x0 = bflo(xw), x1 = bfhi(xw);
#pragma unroll
                for (int tt = 0; tt < 4; ++tt) { const int j = r - tt; if (j >= 0 && j < 31) { o0[tt] += x0 * w0[j]; o1[tt] += x1 * w1[j]; } } }
#pragma unroll
            for (int tt = 0; tt < 4; ++tt) { s1[i][tt] += o0[tt] + o1[tt]; s2[i][tt] += o0[tt] * o0[tt] + o1[tt] * o1[tt];
                CO[(4 * tg + tt) * 384 + slab * 64 + lane] = pk2(o0[tt], o1[tt]); } }
        __syncthreads();
    }
#pragma unroll
    for (int i = 0; i < 2; ++i)
#pragma unroll
        for (int tt = 0; tt < 4; ++tt) { const int t = 4 * (wave + 8 * i) + tt;
            const float mean = wave_sum(s1[i][tt]) * (1.f / 768.f); const float var = fmaxf(wave_sum(s2[i][tt]) * (1.f / 768.f) - mean * mean, 0.f); const float rstd = 1.0f / sqrtf(var + LN_EPS);
            bf16* yp = Y + (size_t)(c0 + t) * D + 512;
#pragma unroll
            for (int k = 0; k < 3; ++k) { const int c = k * 256 + lane * 4; const v2u q = *(const LAS v2u*)(CO + t * 384 + (c >> 1));
                const f32x4 gg = *(const f32x4*)(w.lcg + c), bb = *(const f32x4*)(w.lcb + c);
                float y[4] = {bflo(q.x), bfhi(q.x), bflo(q.y), bfhi(q.y)};
#pragma unroll
                for (int e = 0; e < 4; ++e) { const float z = (y[e] - mean) * rstd * gg[e] + bb[e]; y[e] = z * __builtin_amdgcn_rcpf(1.0f + __builtin_amdgcn_exp2f(z * -1.4426950408889634f)); }
                v2u o; o.x = pk2(y[0], y[1]); o.y = pk2(y[2], y[3]); *(v2u*)(yp + c) = o; } }
    __syncthreads();
}

__device__ __forceinline__ void mixer_phase(LAS unsigned char* lds, const bf16* P, bf16* Y, const MixW& w, int tid, int wave, int lane) {
    for (int u = blockIdx.x; u < M / 128; u += gridDim.x) {
        const int r0 = u * 128;
        sgu_unit(lds, P, Y, w, r0, tid, wave, lane);
        pool_unit(lds, P, Y, w, r0, tid, wave, lane);
        conv_unit(lds, P, Y, w, r0, tid, wave, lane);
        conv_unit(lds, P, Y, w, r0 + 64, tid, wave, lane);
    }
}

#define AS4 __attribute__((address_space(4)))
#define PHASE_BEGIN const AS4 Args* ap = (const AS4 Args*)__builtin_amdgcn_kernarg_segment_ptr(); asm volatile("" : "+s"(ap)); \
    int tid = threadIdx.x; asm volatile("" : "+v"(tid)); const int lane = tid & 63, wave = __builtin_amdgcn_readfirstlane(tid >> 6); (void)lane; (void)wave; \
    unsigned char* ws = ap->ws; (void)ws;
template <int L> __device__ __forceinline__ void layer_phases(LAS unsigned char* lds, cg::grid_group& grid, const int lo, const int hi) {
#define IN(k) (lo <= (k) && (k) < hi)
#define SEAM(k) do { if (IN(k) && IN((k) + 1)) { asm volatile("s_waitcnt vmcnt(0)" ::: "memory"); grid.sync(); __builtin_amdgcn_fence(__ATOMIC_ACQUIRE, "agent"); asm volatile("s_waitcnt vmcnt(0)" ::: "memory"); } } while (0)
    constexpr int pb = 2 + 7 * L;
    if (IN(pb)) { PHASE_BEGIN
        pg8::Gemm g{(const bf16*)(ws + WS_H), (const bf16*)(ws + WS_WIN) + (size_t)L * NIN * D, M, NIN, D}; pg8::StaticOrder S; S.init(M, NIN, (int)gridDim.x, (int)blockIdx.x);
        pg8::EpiInProj E{(bf16*)(ws + WS_P)}; pg8::gemm_phase<pg8::EpiInProj, pg8::StaticOrder, true, true>(lds, g, S, E); }
    SEAM(pb);
    if (IN(pb + 1)) { PHASE_BEGIN
        MixW w; w.wpoolT = (const bf16*)(ws + WS_WPOOL) + (size_t)L * 4 * 128 * 128; w.wsgu = (const bf16*)(ws + WS_WSGU) + (size_t)L * 6 * 128 * 128;
        w.bsgu = ap->in[12] + L * 768; w.lsg = ap->in[13] + L * 768; w.lsb = ap->in[14] + L * 768; w.cw = ap->in[7] + L * 31 * 768; w.cb = ap->in[8] + L * 768; w.lcg = ap->in[9] + L * 768; w.lcb = ap->in[10] + L * 768;
        mixer_phase(lds, (const bf16*)(ws + WS_P), (bf16*)(ws + WS_Y), w, tid, wave, lane); }
    SEAM(pb + 1);
    if (IN(pb + 2)) { PHASE_BEGIN
        pg8::Gemm g{(const bf16*)(ws + WS_Y), (const bf16*)(ws + WS_WOUT) + (size_t)L * D * D, M, D, D}; pg8::StaticOrder S; S.init(M, D, (int)gridDim.x, (int)blockIdx.x);
        float* X = ap->out; pg8::EpiResid E{L == 0 ? ap->in[0] : X, X, (const float*)(ws + WS_MOD) + (size_t)L * NB * NMOD + 2 * D, ALPHA}; pg8::gemm_phase<pg8::EpiResid, pg8::StaticOrder, true, true>(lds, g, S, E); }
    SEAM(pb + 2);
    if (IN(pb + 3)) { PHASE_BEGIN
        float* X = ap->out; const float* modl = (const float*)(ws + WS_MOD) + (size_t)L * NB * NMOD;
        lnmod_phase<true, true, true>(X, X, (bf16*)(ws + WS_H), ap->in[16] + L * D, ap->in[17] + L * D, modl + 3 * D, modl + 4 * D, wave, lane); }
    SEAM(pb + 3);
    if (IN(pb + 4)) { PHASE_BEGIN
        pg8::Gemm g{(const bf16*)(ws + WS_H), (const bf16*)(ws + WS_WFF1) + (size_t)L * DFF * D, M, DFF, D}; pg8::StaticOrder S; S.init(M, DFF, (int)gridDim.x, (int)blockIdx.x);
        pg8::EpiRelu2 E{(bf16*)(ws + WS_BIG)}; pg8::gemm_phase<pg8::EpiRelu2, pg8::StaticOrder, true, true>(lds, g, S, E); }
    SEAM(pb + 4);
    if (IN(pb + 5)) { PHASE_BEGIN
        pg8::Gemm g{(const bf16*)(ws + WS_BIG), (const bf16*)(ws + WS_WFF2) + (size_t)L * D * DFF, M, D, DFF}; pg8::StaticOrder S; S.init(M, D, (int)gridDim.x, (int)blockIdx.x);
        float* X = ap->out; pg8::EpiResid E{X, X, (const float*)(ws + WS_MOD) + (size_t)L * NB * NMOD + 5 * D, ALPHA}; pg8::gemm_phase<pg8::EpiResid, pg8::StaticOrder, true, true>(lds, g, S, E); }
    SEAM(pb + 5);
    if (IN(pb + 6)) { PHASE_BEGIN
        float* X = ap->out; const float* mod1 = (const float*)(ws + WS_MOD) + (size_t)NB * NMOD;
        if (L == 0) lnmod_phase<true, true, true>(X, X, (bf16*)(ws + WS_H), ap->in[20], ap->in[21], mod1 + 0 * D, mod1 + 1 * D, wave, lane);
        else lnmod_phase<true, true, false>(X, X, nullptr, ap->in[20] + D, ap->in[21] + D, nullptr, nullptr, wave, lane); }
    SEAM(pb + 6);
}
__global__ void __launch_bounds__(NTHR, 2) fwd_kernel(Args a_unused) {
    extern __shared__ __attribute__((aligned(16))) unsigned char lds_raw[];
    LAS unsigned char* lds = (LAS unsigned char*)lds_raw;
    cg::grid_group grid = cg::this_grid();
    int lo, hi; { const AS4 Args* ap0 = (const AS4 Args*)__builtin_amdgcn_kernarg_segment_ptr(); lo = ap0->ph_lo; hi = ap0->ph_hi; }
    if (IN(0)) { PHASE_BEGIN prologue_phase(lds, ap, tid, wave, lane); }
    SEAM(0);
    if (IN(1)) { PHASE_BEGIN lnmod_phase<false, false, true>(ap->in[0], nullptr, (bf16*)(ws + WS_H), nullptr, nullptr, (const float*)(ws + WS_MOD) + 0 * D, (const float*)(ws + WS_MOD) + 1 * D, wave, lane); }
    SEAM(1);
#ifdef DBG_LAST
    if (lo >= 100) { PHASE_BEGIN
        const int which = lo - 100; const bf16* src = which == 0 ? (const bf16*)(ws + WS_H) : which == 1 ? (const bf16*)(ws + WS_P) + DBG_COL : which == 2 ? (const bf16*)(ws + WS_Y) : (const bf16*)(ws + WS_BIG) + DBG_COL;
        const int pitch = which == 0 ? D : which == 1 ? PW : which == 2 ? D : DFF; float* X = ap->out;
        for (size_t i = (size_t)blockIdx.x * NTHR + tid; i < (size_t)M * D; i += (size_t)gridDim.x * NTHR) { const size_t m = i >> 11, c = i & 2047; float v = __uint_as_float((unsigned)src[m * pitch + c] << 16); v = (!(fabsf(v) < 1e30f)) ? ((DBG_COND) ? 1000.f : 1.f) : 0.f; X[i] = v; }
        return; }
#endif
    layer_phases<0>(lds, grid, lo, hi);
    layer_phases<1>(lds, grid, lo, hi);
#undef IN
#undef SEAM
}
constexpr int NPHASES = 16;
#ifndef MK_N_LAUNCHES
#define MK_N_LAUNCHES 1
#endif

extern "C" void kernel_launch(void* const* d_in, const int* in_sizes, int n_in, void* d_out, int out_size, void* d_ws, size_t ws_size, hipStream_t stream) {
    static int grid = 0;
    if (grid == 0) {
        if (n_in != 22 || out_size != M * D || ws_size < WS_END) { fprintf(stderr, "kernel_launch: unexpected shapes (n_in %d, out %d, ws %zu < %zu)\n", n_in, out_size, ws_size, (size_t)WS_END); grid = -1; return; }
        int dev = 0, cus = 0, per_cu = 0;
        hipGetDevice(&dev); hipDeviceGetAttribute(&cus, hipDeviceAttributeMultiprocessorCount, dev);
        if (hipFuncSetAttribute((const void*)fwd_kernel, hipFuncAttributeMaxDynamicSharedMemorySize, LDS_BYTES) != hipSuccess) { fprintf(stderr, "kernel_launch: hipFuncSetAttribute failed\n"); grid = -1; return; }
        if (hipOccupancyMaxActiveBlocksPerMultiprocessor(&per_cu, (const void*)fwd_kernel, NTHR, LDS_BYTES) != hipSuccess || per_cu < 1) { fprintf(stderr, "kernel_launch: occupancy query says %d\n", per_cu); per_cu = 1; (void)hipGetLastError(); }
        grid = cus * per_cu;
    }
    if (grid < 0) return;
    Args a{};
    for (int i = 0; i < 22; ++i) a.in[i] = (const float*)d_in[i];
    a.out = (float*)d_out; a.ws = (unsigned char*)d_ws;
    if (MK_N_LAUNCHES == 1) {
        a.ph_lo = 0; a.ph_hi = NPHASES;
        void* args[] = {&a};
        hipError_t e = hipLaunchCooperativeKernel((const void*)fwd_kernel, dim3(grid), dim3(NTHR), args, LDS_BYTES, stream);
        if (e != hipSuccess) fprintf(stderr, "kernel_launch: cooperative launch failed: %s (grid %d)\n", hipGetErrorString(e), grid);
    } else {
#ifdef DBG_LAST
        for (int p = 0; p <= DBG_LAST; ++p) { a.ph_lo = p; a.ph_hi = p + 1; hipLaunchKernelGGL(fwd_kernel, dim3(grid), dim3(NTHR), LDS_BYTES, stream, a); }
        a.ph_lo = 100 + DBG_WHICH; a.ph_hi = 0; hipLaunchKernelGGL(fwd_kernel, dim3(grid), dim3(NTHR), LDS_BYTES, stream, a);
#else
        for (int p = 0; p < NPHASES; ++p) { a.ph_lo = p; a.ph_hi = p + 1; hipLaunchKernelGGL(fwd_kernel, dim3(grid), dim3(NTHR), LDS_BYTES, stream, a); }
#endif
    }
}
```

```cpp
#include <hip/hip_runtime.h>
#include <hip/hip_cooperative_groups.h>
#include <cstdio>
#include <cstdint>
namespace cg = cooperative_groups;
namespace pg8 {
#define PG8_LAS __attribute__((address_space(3)))
typedef unsigned short bf16_t;
typedef short bf16x8 __attribute__((ext_vector_type(8)));
typedef float f32x4 __attribute__((ext_vector_type(4)));
typedef unsigned u32x4 __attribute__((ext_vector_type(4)));
constexpr int BM = 256, BK = 64, HALF = 128, HTB = HALF * BK * 2  , STAGE_BYTES = 8 * HTB, NXCD = 8, WGM = 4;

__host__ __device__ __forceinline__ int lds_byte(int r, int c) { const int st = (r >> 4) * 2 + (c >> 5), rr = r & 15, cc = c & 31, ob = rr * 64 + cc * 2; return st * 1024 + (ob ^ (((ob >> 9) & 1) << 5)); }
__host__ __device__ __forceinline__ void stage_rc(int b, int& R, int& C) { const int st = b / 1024, sb = b % 1024, swz = sb ^ (((sb >> 9) & 1) << 5); R = (st >> 1) * 16 + swz / 64; C = (st & 1) * 32 + (swz % 64) / 2; }
__host__ __device__ __forceinline__ int perm32(int rho) { const int n = rho >> 4, i = rho & 15; return 8 * (i >> 2) + 4 * n + (i & 3); }

struct Unit { int pm, pn; };
struct Gemm { const bf16_t* A; const bf16_t* Bt; int M, N, K; };

struct StaticOrder {
    int nM, nN, nwg, G, c;
    __host__ __device__ void init(int M, int N, int G_, int c_) { nM = M / BM; nN = N / BM; nwg = nM * nN; G = G_; c = c_; }
    __host__ __device__ bool next(int i, Unit& u) const {
        const long L = (long)i * G + c; if (L >= nwg) return false;
        int wgid = (int)L; { const int q = nwg / NXCD, r = nwg % NXCD, xcd = wgid % NXCD, off = wgid / NXCD; wgid = (xcd < r ? xcd * (q + 1) : r * (q + 1) + (xcd - r) * q) + off; }
        const int nig = WGM * nN, gid = wgid / nig, fm = gid * WGM, gsz = (nM - fm) < WGM ? (nM - fm) : WGM;
        u.pm = fm + ((wgid % nig) % gsz); u.pn = (wgid % nig) / gsz; return true;
    }
    __device__ __forceinline__ void a_ready(const Unit&) const {}
    __device__ __forceinline__ void done(const Unit&) const {}
};

typedef __bf16 bf16x2_cv __attribute__((ext_vector_type(2)));
typedef float f32x2_cv __attribute__((ext_vector_type(2)));
__device__ __forceinline__ unsigned cvt_pk_bf16(float lo, float hi) { const f32x2_cv f = {lo, hi}; const bf16x2_cv b = __builtin_convertvector(f, bf16x2_cv); return __builtin_bit_cast(unsigned, b); }
typedef float f32x2 __attribute__((ext_vector_type(2)));
__device__ __forceinline__ f32x2 gelu_pk(f32x2 v) {
    const f32x2 av = __builtin_elementwise_abs(v), d = av * 0.2316418882f + 1.0f;
    f32x2 t; t.x = __builtin_amdgcn_rcpf(d.x); t.y = __builtin_amdgcn_rcpf(d.y);
    f32x2 q = t * 0.5307027145f + (-0.7265760135f); q = q * t + 0.7107068705f; q = q * t + (-0.142248368f); q = q * t + 0.127414796f; q = q * t;
    const f32x2 s = (v * v) * (-0.72134752044f);
    f32x2 e; e.x = __builtin_amdgcn_exp2f(s.x); e.y = __builtin_amdgcn_exp2f(s.y);
    const f32x2 m = v * (q * e), r = v - m;
    f32x2 o; o.x = v.x < 0.f ? m.x : r.x; o.y = v.y < 0.f ? m.y : r.y; return o;
}

constexpr int PW = 2816;
struct EpiInProj {
    static constexpr bool PERM = true, AFTER_DRAIN = false;
    bf16_t* P;
    __device__ __forceinline__ void operator()(const f32x4 (&acc)[2][2][4][2], const Unit& u, int wr, int wc, int fr, int fq) const {
        const int row0 = u.pm * BM + wr * 64 + fr; const int pn = u.pn;
        if (pn >= 2 && pn < 8) {
            const int col0 = 512 + (pn - 2) * 128 + wc * 32 + 8 * fq;
#pragma unroll
            for (int ai = 0; ai < 2; ++ai)
#pragma unroll
                for (int m = 0; m < 4; ++m) { bf16_t* rowp = P + (size_t)(row0 + ai * HALF + m * 16) * PW + col0;
                    float o[8];
#pragma unroll
                    for (int n = 0; n < 2; ++n)
#pragma unroll
                        for (int j = 0; j < 4; ++j) { const float v = acc[ai][0][m][n][j], g = acc[ai][1][m][n][j];
                            o[n * 4 + j] = v * __builtin_amdgcn_rcpf(1.0f + __builtin_amdgcn_exp2f(g * -1.4426950408889634f)); }
                    u32x4 w; w.x = cvt_pk_bf16(o[0], o[1]); w.y = cvt_pk_bf16(o[2], o[3]); w.z = cvt_pk_bf16(o[4], o[5]); w.w = cvt_pk_bf16(o[6], o[7]);
                    *(u32x4*)rowp = w; }
        } else {
            const int colt = pn < 2 ? pn * 256 : 1280 + (pn - 8) * 256; const bool act = pn >= 8;
            const int col0 = colt + wc * 32 + 8 * fq;
#pragma unroll
            for (int ai = 0; ai < 2; ++ai)
#pragma unroll
                for (int m = 0; m < 4; ++m) { bf16_t* rowp = P + (size_t)(row0 + ai * HALF + m * 16) * PW + col0;
#pragma unroll
                    for (int bj = 0; bj < 2; ++bj) { f32x4 v0 = acc[ai][bj][m][0], v1 = acc[ai][bj][m][1];
                        if (act) { f32x2 a = gelu_pk((f32x2){v0[0], v0[1]}), b = gelu_pk((f32x2){v0[2], v0[3]}), c = gelu_pk((f32x2){v1[0], v1[1]}), d = gelu_pk((f32x2){v1[2], v1[3]});
                            v0 = (f32x4){a.x, a.y, b.x, b.y}; v1 = (f32x4){c.x, c.y, d.x, d.y}; }
                        u32x4 w; w.x = cvt_pk_bf16(v0[0], v0[1]); w.y = cvt_pk_bf16(v0[2], v0[3]); w.z = cvt_pk_bf16(v1[0], v1[1]); w.w = cvt_pk_bf16(v1[2], v1[3]);
                        *(u32x4*)(rowp + bj * HALF) = w; } }
        }
    }
};
typedef _Float16 h16x2_cv __attribute__((ext_vector_type(2)));
__device__ __forceinline__ unsigned pk_h2(float lo, float hi) { const f32x2_cv f = {lo, hi}; const h16x2_cv h = __builtin_convertvector(f, h16x2_cv); return __builtin_bit_cast(unsigned, h); }
__device__ __forceinline__ f32x2_cv up_h2(unsigned w) { const h16x2_cv h = __builtin_bit_cast(h16x2_cv, w); return __builtin_convertvector(h, f32x2_cv); }
template <bool RAW, bool LAST> struct EpiResid {
    static constexpr bool PERM = true, AFTER_DRAIN = false;
    const float* xin_f; const bf16_t* xin_h; float* xout_f; bf16_t* xout_h; const float* gate; const float* rstat; const float* lng; const float* lnb; float* part; float alpha; float accs;
    __device__ __forceinline__ void operator()(const f32x4 (&acc)[2][2][4][2], const Unit& u, int wr, int wc, int fr, int fq) const {
        const int row0 = u.pm * BM + wr * 64 + fr, col0 = u.pn * BM + wc * 32 + 8 * fq;
        const float* gp = gate + (size_t)(u.pm >> 3) * 12288 + col0;
        f32x4 gv[2][2], gl[2][2], bl[2][2];
#pragma unroll
        for (int bj = 0; bj < 2; ++bj)
#pragma unroll
            for (int n = 0; n < 2; ++n) { gv[bj][n] = *(const f32x4*)(gp + bj * HALF + n * 4) * accs;
                if (!RAW) { gl[bj][n] = *(const f32x4*)(lng + col0 + bj * HALF + n * 4); bl[bj][n] = *(const f32x4*)(lnb + col0 + bj * HALF + n * 4); } }
#pragma unroll
        for (int ai = 0; ai < 2; ++ai)
#pragma unroll
            for (int m = 0; m < 4; ++m) { const int row = row0 + ai * HALF + m * 16; const size_t off = (size_t)row * 2048 + col0;
                float mean = 0.f, rstd = 1.f; if (!RAW) { const f32x2 st = *(const f32x2*)(rstat + 2 * (size_t)row); mean = st.x; rstd = st.y; }
                float s = 0.f, q = 0.f;
#pragma unroll
                for (int bj = 0; bj < 2; ++bj) { f32x4 x0, x1;
                    if (RAW) { x0 = *(const f32x4*)(xin_f + off + bj * HALF); x1 = *(const f32x4*)(xin_f + off + bj * HALF + 4); }
                    else { const u32x4 w = *(const u32x4*)(xin_h + off + bj * HALF);
                        { const f32x2_cv a = up_h2(w.x), b = up_h2(w.y), c = up_h2(w.z), d = up_h2(w.w); x0 = (f32x4){a.x, a.y, b.x, b.y}; x1 = (f32x4){c.x, c.y, d.x, d.y}; }
                        x0 = (x0 - mean) * rstd * gl[bj][0] + bl[bj][0]; x1 = (x1 - mean) * rstd * gl[bj][1] + bl[bj][1]; }
                    f32x4 o0 = x0 * alpha + gv[bj][0] * acc[ai][bj][m][0], o1 = x1 * alpha + gv[bj][1] * acc[ai][bj][m][1];
                    if (LAST) { *(f32x4*)(xout_f + off + bj * HALF) = o0; *(f32x4*)(xout_f + off + bj * HALF + 4) = o1; }
                    else { u32x4 w; w.x = pk_h2(o0[0], o0[1]); w.y = pk_h2(o0[2], o0[3]); w.z = pk_h2(o1[0], o1[1]); w.w = pk_h2(o1[2], o1[3]);
                        *(u32x4*)(xout_h + off + bj * HALF) = w;
                        const f32x2_cv a = up_h2(w.x), b = up_h2(w.y), c = up_h2(w.z), d = up_h2(w.w); o0 = (f32x4){a.x, a.y, b.x, b.y}; o1 = (f32x4){c.x, c.y, d.x, d.y}; }
                    s += ((o0[0] + o0[1]) + (o0[2] + o0[3])) + ((o1[0] + o1[1]) + (o1[2] + o1[3]));
                    q += ((o0[0] * o0[0] + o0[1] * o0[1]) + (o0[2] * o0[2] + o0[3] * o0[3])) + ((o1[0] * o1[0] + o1[1] * o1[1]) + (o1[2] * o1[2] + o1[3] * o1[3])); }
                s += __shfl_xor(s, 16); s += __shfl_xor(s, 32); q += __shfl_xor(q, 16); q += __shfl_xor(q, 32);
                if (fq == 0) *(f32x2*)(part + ((size_t)row * 32 + u.pn * 4 + wc) * 2) = (f32x2){s, q};
                asm volatile("" ::: "memory"); }
    }
};
template <bool F8> struct EpiRelu2 {
    static constexpr bool PERM = true, AFTER_DRAIN = false;
    bf16_t* O;
    __device__ __forceinline__ void operator()(const f32x4 (&acc)[2][2][4][2], const Unit& u, int wr, int wc, int fr, int fq) const {
        const int row0 = u.pm * BM + wr * 64 + fr, col0 = u.pn * BM + wc * 32 + 8 * fq;
#pragma unroll
        for (int ai = 0; ai < 2; ++ai)
#pragma unroll
            for (int m = 0; m < 4; ++m) {
#pragma unroll
                for (int bj = 0; bj < 2; ++bj) { f32x4 v0 = acc[ai][bj][m][0], v1 = acc[ai][bj][m][1];
#pragma unroll
                    for (int j = 0; j < 4; ++j) { const float a = fmaxf(v0[j], 0.f), b = fmaxf(v1[j], 0.f); v0[j] = a * a; v1[j] = b * b; }
                    if (F8) { unsigned char* rowp = (unsigned char*)O + (size_t)(row0 + ai * HALF + m * 16) * 8192 + col0 + bj * HALF;
                        int w0 = 0, w1 = 0; w0 = __builtin_amdgcn_cvt_pk_fp8_f32(v0[0], v0[1], w0, false); w0 = __builtin_amdgcn_cvt_pk_fp8_f32(v0[2], v0[3], w0, true);
                        w1 = __builtin_amdgcn_cvt_pk_fp8_f32(v1[0], v1[1], w1, false); w1 = __builtin_amdgcn_cvt_pk_fp8_f32(v1[2], v1[3], w1, true);
                        typedef unsigned u32x2_f8 __attribute__((ext_vector_type(2))); *(u32x2_f8*)rowp = (u32x2_f8){(unsigned)w0, (unsigned)w1}; }
                    else { bf16_t* rowp = O + (size_t)(row0 + ai * HALF + m * 16) * 8192 + col0;
                        u32x4 w; w.x = cvt_pk_bf16(v0[0], v0[1]); w.y = cvt_pk_bf16(v0[2], v0[3]); w.z = cvt_pk_bf16(v1[0], v1[1]); w.w = cvt_pk_bf16(v1[2], v1[3]);
                        *(u32x4*)(rowp + bj * HALF) = w; } } }
    }
};

struct EpiNull {
    static constexpr bool PERM = true, AFTER_DRAIN = false;
    bf16_t* O;
    __device__ __forceinline__ void operator()(const f32x4 (&acc)[2][2][4][2], const Unit& u, int wr, int wc, int fr, int fq) const {
        f32x4 s = (f32x4){0.f, 0.f, 0.f, 0.f};
#pragma unroll
        for (int ai = 0; ai < 2; ++ai)
#pragma unroll
            for (int bj = 0; bj < 2; ++bj)
#pragma unroll
                for (int m = 0; m < 4; ++m)
#pragma unroll
                    for (int n = 0; n < 2; ++n) s += acc[ai][bj][m][n];
        if (s[0] + s[1] + s[2] + s[3] == 1234.56789f) O[(size_t)u.pm * 7 + fr] = 1;
    }
};
typedef int i32x4_f8 __attribute__((ext_vector_type(4)));
typedef int i32x8_f8 __attribute__((ext_vector_type(8)));
template <class Epi, class Sched, bool ALIGN_EPI = false, bool SP2 = false, bool F8 = false>
__device__ __forceinline__ void gemm_phase(PG8_LAS unsigned char* lds, const Gemm g, const Sched& S, const Epi& E) {
    int tid_ = threadIdx.x; asm volatile("" : "+v"(tid_)); const int tid = tid_, wid = __builtin_amdgcn_readfirstlane(tid >> 6), lane = tid & 63, wr = wid >> 2, wc = wid & 3, fr = lane & 15, fq = lane >> 4;
    const int K = g.K, nt = K / BK;
    unsigned voffA[2], voffB[2];
#pragma unroll
    for (int i = 0; i < 2; ++i) { int R, C; stage_rc(tid * 16 + i * 8192, R, C); const int Rb = Epi::PERM ? ((R & ~31) + perm32(R & 31)) : R;
        voffA[i] = (unsigned)(R * K + C) * 2u; voffB[i] = (unsigned)(Rb * K + C) * 2u; }
    const size_t kstep = (size_t)(BK * 2);
    const size_t hstep = (size_t)HALF * K * 2;
    const size_t tstep = 2 * hstep;
    const unsigned ldsw = (unsigned)wid * 1024u;
    const int aoff = lds_byte(wr * 64 + fr, fq * 8), boff = lds_byte(wc * 32 + fr, fq * 8);
#define PG8_SA(b, h) (((b) * 2 + (h)) * HTB)
#define PG8_SB(b, h) ((4 + (b) * 2 + (h)) * HTB)
#define PG8_STAGE(bufoff, gbase, voff) do { _Pragma("unroll") for (int _i = 0; _i < 2; ++_i) \
        __builtin_amdgcn_global_load_lds((const unsigned*)((const char*)(gbase) + (voff)[_i]), (PG8_LAS unsigned*)(lds + (bufoff) + ldsw + _i * 8192), 16, 0, 0); } while (0)
#define PG8_LDA(dst, b, h) do { if constexpr (F8) { _Pragma("unroll") for (int m = 0; m < 4; ++m) { const i32x4_f8 l0_ = *(const PG8_LAS i32x4_f8*)(lds + PG8_SA(b, h) + aoff + m * 2048), l1_ = *(const PG8_LAS i32x4_f8*)(lds + PG8_SA(b, h) + aoff + m * 2048 + 1024); \
        dst##8[m] = __builtin_shufflevector(l0_, l1_, 0, 1, 2, 3, 4, 5, 6, 7); } } else { _Pragma("unroll") for (int m = 0; m < 4; ++m) _Pragma("unroll") for (int k = 0; k < 2; ++k) dst[m][k] = *(const PG8_LAS bf16x8*)(lds + PG8_SA(b, h) + aoff + m * 2048 + k * 1024); } } while (0)
#define PG8_LDB(dst, b, h) do { if constexpr (F8) { _Pragma("unroll") for (int n = 0; n < 2; ++n) { const i32x4_f8 l0_ = *(const PG8_LAS i32x4_f8*)(lds + PG8_SB(b, h) + boff + n * 2048), l1_ = *(const PG8_LAS i32x4_f8*)(lds + PG8_SB(b, h) + boff + n * 2048 + 1024); \
        dst##8[n] = __builtin_shufflevector(l0_, l1_, 0, 1, 2, 3, 4, 5, 6, 7); } } else { _Pragma("unroll") for (int n = 0; n < 2; ++n) _Pragma("unroll") for (int k = 0; k < 2; ++k) dst[n][k] = *(const PG8_LAS bf16x8*)(lds + PG8_SB(b, h) + boff + n * 2048 + k * 1024); } } while (0)
#define PG8_MMA(ai, bj, At, Bt) do { __builtin_amdgcn_s_setprio(1); if constexpr (F8) { _Pragma("unroll") for (int m = 0; m < 4; ++m) _Pragma("unroll") for (int n = 0; n < 2; ++n) \
        asm volatile("v_mfma_scale_f32_16x16x128_f8f6f4 %0, %1, %2, %0, %3, %3 op_sel_hi:[0,0,0]" : "+v"(acc[ai][bj][m][n]) : "v"(Bt##8[n]), "v"(At##8[m]), "v"(sc1_)); } else { \
        _Pragma("unroll") for (int m = 0; m < 4; ++m) _Pragma("unroll") for (int n = 0; n < 2; ++n) _Pragma("unroll") for (int k = 0; k < 2; ++k) \
        acc[ai][bj][m][n] = __builtin_amdgcn_mfma_f32_16x16x32_bf16(Bt[n][k], At[m][k], acc[ai][bj][m][n], 0, 0, 0); } __builtin_amdgcn_s_setprio(0); } while (0)
#define PG8_WAIT_V(n) asm volatile("s_waitcnt vmcnt(" #n ")" ::: "memory")
#define PG8_WAIT_L(n) asm volatile("s_waitcnt lgkmcnt(" #n ")" ::: "memory")
#define PG8_BAR __builtin_amdgcn_s_barrier()
#define PG8_SCHED __builtin_amdgcn_sched_barrier(0)
    Unit cur, nxt; int ui = 0;
    if (!S.next(0, cur)) return;
    f32x4 acc[2][2][4][2];
#pragma unroll
    for (int a = 0; a < 2; ++a)
#pragma unroll
        for (int b = 0; b < 2; ++b)
#pragma unroll
            for (int m = 0; m < 4; ++m)
#pragma unroll
                for (int n = 0; n < 2; ++n) acc[a][b][m][n] = (f32x4){0.f, 0.f, 0.f, 0.f};
    int sc1_ = 0x7f7f7f7f; asm volatile("" : "+v"(sc1_));
    bf16x8 At[4][2], B0[2][2], B1[2][2]; i32x8_f8 At8[4], B08[2], B18[2]; (void)At; (void)B0; (void)B1; (void)At8; (void)B08; (void)B18;
    const char* cA = (const char*)g.A + (size_t)cur.pm * tstep; const char* cB = (const char*)g.Bt + (size_t)cur.pn * tstep;
    S.a_ready(cur);
    if constexpr (SP2) {
        PG8_STAGE(PG8_SB(0, 0), cB, voffB); PG8_STAGE(PG8_SB(0, 1), cB + hstep, voffB); PG8_STAGE(PG8_SA(0, 0), cA, voffA); PG8_STAGE(PG8_SA(0, 1), cA + hstep, voffA);
        if (wr == 1) PG8_BAR;
        PG8_WAIT_V(2); PG8_BAR;
        PG8_STAGE(PG8_SB(1, 0), cB + kstep, voffB); PG8_STAGE(PG8_SA(1, 0), cA + kstep, voffA); PG8_STAGE(PG8_SB(1, 1), cB + hstep + kstep, voffB);
        PG8_WAIT_V(6); PG8_BAR;
    } else {
        PG8_STAGE(PG8_SB(0, 0), cB, voffB); PG8_STAGE(PG8_SA(0, 0), cA, voffA); PG8_STAGE(PG8_SB(0, 1), cB + hstep, voffB); PG8_STAGE(PG8_SA(0, 1), cA + hstep, voffA);
        if (wr == 1) PG8_BAR;
        PG8_WAIT_V(4); PG8_BAR;
        PG8_STAGE(PG8_SB(1, 0), cB + kstep, voffB); PG8_STAGE(PG8_SA(1, 0), cA + kstep, voffA); PG8_STAGE(PG8_SB(1, 1), cB + hstep + kstep, voffB);
        PG8_WAIT_V(6); PG8_BAR;
    }
    for (;;) {
        const bool has_next = S.next(ui + 1, nxt);
        const char* nA = has_next ? (const char*)g.A + (size_t)nxt.pm * tstep : cA; const char* nB = has_next ? (const char*)g.Bt + (size_t)nxt.pn * tstep : cB;
        for (int t = 0; t < nt; t += 2) {
            const bool last = (t == nt - 2);
            const char* a1 = cA + (size_t)(t + 1) * kstep;
            const char* a2 = last ? nA : cA + (size_t)(t + 2) * kstep; const char* b2 = last ? nB : cB + (size_t)(t + 2) * kstep;
            const char* a3 = a2 + kstep; const char* b3 = b2 + kstep;
            if (last && has_next) S.a_ready(nxt);
            if constexpr (SP2) {
            PG8_LDB(B0, 0, 0); PG8_LDB(B1, 0, 1); PG8_SCHED; PG8_LDA(At, 0, 0); PG8_STAGE(PG8_SA(1, 1), a1 + hstep, voffA);
            PG8_WAIT_V(8); PG8_WAIT_L(0); PG8_BAR; PG8_MMA(0, 0, At, B0); PG8_MMA(0, 1, At, B1); PG8_BAR; PG8_SCHED;
            PG8_LDA(At, 0, 1); PG8_STAGE(PG8_SB(0, 0), b2, voffB); PG8_STAGE(PG8_SB(0, 1), b2 + hstep, voffB); PG8_STAGE(PG8_SA(0, 0), a2, voffA);
            PG8_WAIT_V(8); PG8_WAIT_L(0); PG8_BAR; PG8_MMA(1, 0, At, B0); PG8_MMA(1, 1, At, B1); PG8_BAR; PG8_SCHED;
            PG8_LDB(B0, 1, 0); PG8_LDB(B1, 1, 1); PG8_SCHED; PG8_LDA(At, 1, 0); PG8_STAGE(PG8_SA(0, 1), a2 + hstep, voffA);
            PG8_WAIT_V(8); PG8_WAIT_L(0); PG8_BAR; PG8_MMA(0, 0, At, B0); PG8_MMA(0, 1, At, B1); PG8_BAR; PG8_SCHED;
            PG8_LDA(At, 1, 1); PG8_STAGE(PG8_SB(1, 0), b3, voffB); PG8_STAGE(PG8_SB(1, 1), b3 + hstep, voffB); PG8_STAGE(PG8_SA(1, 0), a3, voffA);
            PG8_WAIT_V(8); PG8_WAIT_L(0); PG8_BAR; PG8_MMA(1, 0, At, B0); PG8_MMA(1, 1, At, B1); PG8_BAR; PG8_SCHED;
            } else {
            PG8_LDB(B0, 0, 0); PG8_SCHED; PG8_LDA(At, 0, 0); PG8_STAGE(PG8_SA(1, 1), a1 + hstep, voffA);
            PG8_WAIT_L(8); PG8_BAR; PG8_WAIT_L(0); PG8_MMA(0, 0, At, B0); PG8_BAR; PG8_SCHED;
            PG8_LDB(B1, 0, 1); PG8_STAGE(PG8_SB(0, 0), b2, voffB);
            PG8_BAR; PG8_WAIT_L(0); PG8_MMA(0, 1, At, B1); PG8_BAR;
            PG8_LDA(At, 0, 1); PG8_STAGE(PG8_SA(0, 0), a2, voffA);
            PG8_BAR; PG8_WAIT_L(0); PG8_MMA(1, 0, At, B0); PG8_BAR; PG8_SCHED;
            PG8_STAGE(PG8_SB(0, 1), b2 + hstep, voffB);
            PG8_WAIT_V(6); PG8_BAR; PG8_MMA(1, 1, At, B1); PG8_BAR;
            PG8_LDB(B0, 1, 0); PG8_SCHED; PG8_LDA(At, 1, 0); PG8_STAGE(PG8_SA(0, 1), a2 + hstep, voffA);
            PG8_WAIT_L(8); PG8_BAR; PG8_WAIT_L(0); PG8_MMA(0, 0, At, B0); PG8_BAR; PG8_SCHED;
            PG8_LDB(B1, 1, 1); PG8_STAGE(PG8_SB(1, 0), b3, voffB);
            PG8_BAR; PG8_WAIT_L(0); PG8_MMA(0, 1, At, B1); PG8_BAR;
            PG8_LDA(At, 1, 1); PG8_STAGE(PG8_SA(1, 0), a3, voffA);
            PG8_BAR; PG8_WAIT_L(0); PG8_MMA(1, 0, At, B0); PG8_BAR; PG8_SCHED;
            PG8_STAGE(PG8_SB(1, 1), b3 + hstep, voffB);
            PG8_WAIT_V(6); PG8_BAR; PG8_MMA(1, 1, At, B1); PG8_BAR;
            }
        }
        if constexpr (F8) { asm volatile("s_nop 15\n\ts_nop 15" ::: "memory"); }
        if constexpr (ALIGN_EPI) { if (wr == 0) PG8_BAR; }
        if constexpr (!Epi::AFTER_DRAIN) { E(acc, cur, wr, wc, fr, fq); S.done(cur); }
        if (!has_next) break;
#pragma unroll
        for (int a = 0; a < 2; ++a)
#pragma unroll
            for (int b = 0; b < 2; ++b)
#pragma unroll
                for (int m = 0; m < 4; ++m)
#pragma unroll
                    for (int n = 0; n < 2; ++n) acc[a][b][m][n] = (f32x4){0.f, 0.f, 0.f, 0.f};
        cur = nxt; cA = nA; cB = nB; ++ui;
        if constexpr (ALIGN_EPI) { if (wr == 1) PG8_BAR; }
    }
    PG8_WAIT_V(0);
    if constexpr (!ALIGN_EPI) { if (wr == 0) PG8_BAR; }
    PG8_BAR;
    if constexpr (Epi::AFTER_DRAIN) { E.fused(acc, cur, wr, wc, fr, fq, lds, wid, lane); S.done(cur); }
#undef PG8_SA
#undef PG8_SB
#undef PG8_STAGE
#undef PG8_LDA
#undef PG8_LDB
#undef PG8_MMA
#undef PG8_WAIT_V
#undef PG8_WAIT_L
#undef PG8_BAR
#undef PG8_SCHED
}
}

#define LAS __attribute__((address_space(3)))
typedef unsigned short bf16;
typedef unsigned v4u __attribute__((ext_vector_type(4)));
typedef unsigned v2u __attribute__((ext_vector_type(2)));
typedef float f32x4 __attribute__((ext_vector_type(4)));
typedef float f32x2 __attribute__((ext_vector_type(2)));
typedef short bf16x8 __attribute__((ext_vector_type(8)));
constexpr int NB = 16, SEQ = 2048, D = 2048, M = NB * SEQ, DFF = 8192, NIN = 3584, PW = pg8::PW, NMOD = 12288;
constexpr float LN_EPS = 1e-5f, ALPHA = 1.4142135623730951f;
constexpr int NWAVES = 8, NTHR = 512;
constexpr int LDS_BYTES = 147456;
constexpr size_t MiB = 1u << 20;
constexpr size_t WS_MOD = 0;
constexpr size_t WS_WPOOL = 3 * MiB / 2;
constexpr size_t WS_WSGU = 2 * MiB;
constexpr size_t WS_WIN = 4 * MiB, WS_WOUT = 32 * MiB, WS_WFF1 = 48 * MiB, WS_WFF2 = 112 * MiB;
constexpr size_t WS_H = 176 * MiB;
constexpr size_t WS_BIG = 304 * MiB;
constexpr size_t WS_P = WS_BIG, WS_Y = WS_BIG + 224 * MiB;
constexpr size_t WS_R = WS_BIG + 512 * MiB;
constexpr size_t WS_PART = WS_R + 128 * MiB;
constexpr size_t WS_BAR = 3 * MiB, BAR_BYTES = 16384;
constexpr int LDS_BARW = 139264;
constexpr size_t WS_RSTAT = 5 * MiB / 2;
constexpr size_t WS_END = WS_PART + 8 * MiB;

#define LDS_WAIT() asm volatile("s_waitcnt lgkmcnt(0)" ::: "memory")
__device__ __forceinline__ unsigned pk2(float lo, float hi) { return pg8::cvt_pk_bf16(lo, hi); }
__device__ __forceinline__ float bflo(unsigned w) { return __uint_as_float(w << 16); }
__device__ __forceinline__ float bfhi(unsigned w) { return __uint_as_float(w & 0xffff0000u); }
__device__ __forceinline__ float wave_sum(float v) {
#pragma unroll
    for (int o = 1; o < 64; o <<= 1) v += __shfl_xor(v, o);
    return v;
}

struct Args { const float* in[22]; float* out; unsigned char* ws; int ph_lo, ph_hi; };

__device__ __forceinline__ void transpose_item(const float* W, int ldw, int K, int srccol0, bf16* WT, int dstrow0, int k0, LAS float* scr, int lane) {
#pragma unroll 8
    for (int i = 0; i < 32; ++i) { const int kk = 2 * i + (lane >> 5); scr[kk * 33 + (lane & 31)] = W[(size_t)(k0 + kk) * ldw + srccol0 + (lane & 31)]; }
    LDS_WAIT();
    const int c = lane & 7;
#pragma unroll
    for (int j = 0; j < 4; ++j) { const int n = (lane >> 3) + 8 * j; const LAS float* s = scr + (8 * c) * 33 + n;
        v4u o; o.x = pk2(s[0 * 33], s[1 * 33]); o.y = pk2(s[2 * 33], s[3 * 33]); o.z = pk2(s[4 * 33], s[5 * 33]); o.w = pk2(s[6 * 33], s[7 * 33]);
        *(v4u*)(WT + (size_t)(dstrow0 + n) * K + k0 + 8 * c) = o; }
    LDS_WAIT();
}
constexpr int FP8_OUT_LAYER = 1;
__device__ __forceinline__ void transpose_item_f8(const float* W, int ldw, int K, int srccol0, unsigned char* WT8, int dstrow0, int k0, float scl, LAS float* scr, int lane) {
#pragma unroll 8
    for (int i = 0; i < 32; ++i) { const int kk = 2 * i + (lane >> 5); scr[kk * 33 + (lane & 31)] = W[(size_t)(k0 + kk) * ldw + srccol0 + (lane & 31)]; }
    LDS_WAIT();
    const int c = lane & 7;
#pragma unroll
    for (int j = 0; j < 4; ++j) { const int n = (lane >> 3) + 8 * j; const LAS float* sp = scr + (8 * c) * 33 + n;
        int w0 = 0, w1 = 0; w0 = __builtin_amdgcn_cvt_pk_fp8_f32(sp[0 * 33] * scl, sp[1 * 33] * scl, w0, false); w0 = __builtin_amdgcn_cvt_pk_fp8_f32(sp[2 * 33] * scl, sp[3 * 33] * scl, w0, true);
        w1 = __builtin_amdgcn_cvt_pk_fp8_f32(sp[4 * 33] * scl, sp[5 * 33] * scl, w1, false); w1 = __builtin_amdgcn_cvt_pk_fp8_f32(sp[6 * 33] * scl, sp[7 * 33] * scl, w1, true);
        *(v2u*)(WT8 + (size_t)(dstrow0 + n) * K + k0 + 8 * c) = (v2u){(unsigned)w0, (unsigned)w1}; }
    LDS_WAIT();
}
__device__ __forceinline__ void prologue_phase(LAS unsigned char* lds, const __attribute__((address_space(4))) Args* ap, int tid, int wave, int lane) {
    unsigned char* ws = ap->ws;
    {
        LAS float* CA = (LAS float*)lds;
        const float* c = ap->in[1]; const float* wm = ap->in[2]; const float* bm = ap->in[3]; float* mod = (float*)(ws + WS_MOD);
        for (int it = blockIdx.x; it < 192; it += gridDim.x) {
            for (int i = tid; i < NB * D; i += NTHR) { const int b = i >> 11, k = i & 2047; const float v = c[i]; CA[k * 16 + b] = v * __builtin_amdgcn_rcpf(1.0f + __builtin_amdgcn_exp2f(v * -1.4426950408889634f)); }
            __syncthreads();
            const int gc0 = it * 128, l = gc0 / NMOD, j0 = gc0 % NMOD, ks = tid >> 5, cl = tid & 31;
            const float* wp = wm + (size_t)l * D * NMOD + (size_t)(ks * 128) * NMOD + j0 + cl * 4;
            f32x4 acc[16];
#pragma unroll
            for (int b = 0; b < 16; ++b) acc[b] = (f32x4){0.f, 0.f, 0.f, 0.f};
#pragma unroll 4
            for (int k = 0; k < 128; ++k) {
                const f32x4 w = *(const f32x4*)(wp + (size_t)k * NMOD);
                const LAS f32x4* cp = (const LAS f32x4*)(CA + (ks * 128 + k) * 16);
#pragma unroll
                for (int q = 0; q < 4; ++q) { const f32x4 cv = cp[q];
#pragma unroll
                    for (int e = 0; e < 4; ++e) acc[q * 4 + e] += w * cv[e]; }
            }
            __syncthreads();
#pragma unroll
            for (int b = 0; b < 16; ++b) *(LAS f32x4*)(CA + (ks * 16 + b) * 128 + cl * 4) = acc[b];
            __syncthreads();
            for (int o = tid; o < 16 * 128; o += NTHR) { const int b = o >> 7, cc = o & 127; float s = bm[(size_t)l * NMOD + j0 + cc];
#pragma unroll
                for (int q = 0; q < 16; ++q) s += CA[(q * 16 + b) * 128 + cc];
                mod[((size_t)l * NB + b) * NMOD + j0 + cc] = s; }
            __syncthreads();
        }
    }
    {
        bf16* wpl = (bf16*)(ws + WS_WPOOL); const float* wp = ap->in[5]; const float* ls = ap->in[6];
        for (int i = blockIdx.x * NTHR + tid; i < 2 * 4 * 128 * 128; i += gridDim.x * NTHR) { const int c = i & 127, d = (i >> 7) & 127, lg = i >> 14;
            wpl[i] = (bf16)(pk2(wp[((size_t)lg * 128 + c) * 128 + d] * ls[lg * 128 + d], 0.f) & 0xffffu); }
        bf16* wsg = (bf16*)(ws + WS_WSGU); const float* wsf = ap->in[11];
        for (int i = blockIdx.x * NTHR + tid; i < 2 * 6 * 128 * 128; i += gridDim.x * NTHR) { const int s = i & 127, t = (i >> 7) & 127;
            wsg[i] = (bf16)(pk2(s <= t ? wsf[i] : 0.f, 0.f) & 0xffffu); }
    }
    {
        LAS float* scr = (LAS float*)(lds + wave * 16384);
        const int gw = blockIdx.x * NWAVES + wave, NGW = gridDim.x * NWAVES;
        constexpr int I_IN = 32 * 112, I_OUT = 32 * 64, I_F1 = 32 * 256, I_F2 = 128 * 64, I_L = I_IN + I_OUT + I_F1 + I_F2;
        for (int it = gw; it < 2 * I_L; it += NGW) {
            const int l = it / I_L; int r = it % I_L;
            if (r < I_IN) { const int kb = r / 112, n0 = (r % 112) * 32, tile = n0 >> 8, within = n0 & 255;
                const int src = (tile >= 2 && tile < 8) ? 512 + (within >> 7) * 768 + (tile - 2) * 128 + (within & 127) : n0;
                transpose_item(ap->in[4] + (size_t)l * D * NIN, NIN, D, src, (bf16*)(ws + WS_WIN) + (size_t)l * NIN * D, n0, kb * 64, scr, lane); continue; }
            r -= I_IN;
            if (r < I_OUT) { if (l == FP8_OUT_LAYER) transpose_item_f8(ap->in[15] + (size_t)l * D * D, D, D, (r % 64) * 32, (unsigned char*)((bf16*)(ws + WS_WOUT) + (size_t)l * D * D), (r % 64) * 32, (r / 64) * 64, 64.0f, scr, lane);
                else transpose_item(ap->in[15] + (size_t)l * D * D, D, D, (r % 64) * 32, (bf16*)(ws + WS_WOUT) + (size_t)l * D * D, (r % 64) * 32, (r / 64) * 64, scr, lane); continue; }
            r -= I_OUT;
            if (r < I_F1) { transpose_item(ap->in[18] + (size_t)l * D * DFF, DFF, D, (r % 256) * 32, (bf16*)(ws + WS_WFF1) + (size_t)l * DFF * D, (r % 256) * 32, (r / 256) * 64, scr, lane); continue; }
            r -= I_F1;
            transpose_item(ap->in[19] + (size_t)l * DFF * D, D, DFF, (r % 64) * 32, (bf16*)(ws + WS_WFF2) + (size_t)l * D * DFF, (r % 64) * 32, (r / 64) * 64, scr, lane);
        }
    }
}

template <bool SRCH> struct LnRow { typedef f32x4 T; static __device__ __forceinline__ f32x4 up(const f32x4 v) { return v; } };
template <> struct LnRow<true> { typedef v2u T; static __device__ __forceinline__ f32x4 up(const v2u v) { const pg8::f32x2_cv a = pg8::up_h2(v.x), b = pg8::up_h2(v.y); return (f32x4){a.x, a.y, b.x, b.y}; } };
template <bool SRCH, bool STATS, bool WX, bool WH>
__device__ __forceinline__ void lnmod_phase(const void* srcv, float* xout, bf16* hout, const float* g, const float* bt, const float* shift, const float* scale, const float* part, float* rstat, int wave, int lane) {
    typedef typename LnRow<SRCH>::T RT;
    const RT* src = (const RT*)srcv;
    const int gw = blockIdx.x * NWAVES + wave, NGW = gridDim.x * NWAVES;
    for (int blk = gw; blk < M / 16; blk += NGW) {
        const int m0 = blk * 16, b = m0 >> 11;
        f32x4 G[8], Bc[8];
#pragma unroll
        for (int j = 0; j < 8; ++j) { f32x4 gg = (f32x4){1.f, 1.f, 1.f, 1.f}, bb = (f32x4){0.f, 0.f, 0.f, 0.f};
            if (STATS) { gg = *((const f32x4*)g + 64 * j + lane); bb = *((const f32x4*)bt + 64 * j + lane); }
            if (WH) { const f32x4 sc = *((const f32x4*)(scale + (size_t)b * NMOD) + 64 * j + lane) + 1.0f, sh = *((const f32x4*)(shift + (size_t)b * NMOD) + 64 * j + lane); gg = gg * sc; bb = bb * sc + sh; }
            G[j] = gg; Bc[j] = bb; }
        RT cur[8], nxt[8]; f32x2 pc = (f32x2){0.f, 0.f}, pn = (f32x2){0.f, 0.f};
        { const RT* xr = src + (size_t)m0 * 512 + lane;
#pragma unroll
          for (int j = 0; j < 8; ++j) { cur[j] = xr[64 * j]; nxt[j] = cur[j]; }
          if (STATS && lane < 32) pc = *((const f32x2*)(part + (size_t)m0 * 64) + lane); }
        for (int i = 0; i < 16; ++i) {
            const int m = m0 + i;
            if (i < 15) { const RT* xr = src + (size_t)(m + 1) * 512 + lane;
#pragma unroll
                for (int j = 0; j < 8; ++j) nxt[j] = xr[64 * j];
                if (STATS && lane < 32) pn = *((const f32x2*)(part + (size_t)(m + 1) * 64) + lane); }
            float mean = 0.f, rstd = 1.f;
            if (STATS) { const float S = wave_sum(pc.x), Q = wave_sum(pc.y); mean = S * (1.f / D); const float var = fmaxf(Q * (1.f / D) - mean * mean, 0.f); rstd = 1.0f / sqrtf(var + LN_EPS);
                if (!WX && lane == 0) *(f32x2*)(rstat + 2 * (size_t)m) = (f32x2){mean, rstd}; }
            const float ms = mean * rstd;
            if (WX) { f32x4* xo = (f32x4*)(xout + (size_t)m * D) + lane;
#pragma unroll
                for (int j = 0; j < 8; ++j) xo[64 * j] = (LnRow<SRCH>::up(cur[j]) * rstd - ms) * G[j] + Bc[j]; }
            if (WH) { v2u* ho = (v2u*)(hout + (size_t)m * D) + lane;
#pragma unroll
                for (int j = 0; j < 8; ++j) { const f32x4 h = (LnRow<SRCH>::up(cur[j]) * rstd - ms) * G[j] + Bc[j]; v2u w; w.x = pk2(h[0], h[1]); w.y = pk2(h[2], h[3]); ho[64 * j] = w; } }
#pragma unroll
            for (int j = 0; j < 8; ++j) cur[j] = nxt[j];
            pc = pn;
        }
    }
}

__device__ __forceinline__ void y_store4(bf16* Y, bool y8, size_t row, int col, float a, float b, float c, float d) {
    if (y8) { int wq = 0; wq = __builtin_amdgcn_cvt_pk_fp8_f32(a, b, wq, false); wq = __builtin_amdgcn_cvt_pk_fp8_f32(c, d, wq, true); *(unsigned*)((unsigned char*)Y + row * 2048 + col) = (unsigned)wq; }
    else { v2u o; o.x = pk2(a, b); o.y = pk2(c, d); *(v2u*)(Y + row * 2048 + col) = o; }
}
struct MixW { bool y8; const bf16* wpoolT; const bf16* wsgu; const float* bsgu; const float* lsg; const float* lsb; const float* cw; const float* cb; const float* lcg; const float* lcb; };

__device__ __forceinline__ void sgu_unit(LAS unsigned char* lds, const bf16* P, bf16* Y, const MixW& w, int r0, int tid, int wave, int lane) {
    LAS float* ST = (LAS float*)lds;
    LAS bf16* VT = (LAS bf16*)(lds + 1024);
    for (int i = 0; i < 16; ++i) { const int t = wave * 16 + i; const bf16* vr = P + (size_t)(r0 + t) * PW + 2048;
        float x[12];
#pragma unroll
        for (int k = 0; k < 3; ++k) { const v2u q = *(const v2u*)(vr + k * 256 + lane * 4); x[4 * k] = bflo(q.x); x[4 * k + 1] = bfhi(q.x); x[4 * k + 2] = bflo(q.y); x[4 * k + 3] = bfhi(q.y); }
        float s = 0.f;
#pragma unroll
        for (int k = 0; k < 12; ++k) s += x[k];
        const float mean = wave_sum(s) * (1.f / 768.f); float qq = 0.f;
#pragma unroll
        for (int k = 0; k < 12; ++k) { const float dlt = x[k] - mean; qq += dlt * dlt; }
        const float rstd = 1.0f / sqrtf(wave_sum(qq) * (1.f / 768.f) + LN_EPS);
        if (lane == 0) { ST[2 * t] = mean; ST[2 * t + 1] = rstd; } }
    __syncthreads();
    for (int h = 0; h < 6; ++h) {
        { const int s = tid & 127, dg = tid >> 7; const bf16* vr = P + (size_t)(r0 + s) * PW + 2048 + h * 128 + dg * 32; const float mean = ST[2 * s], rstd = ST[2 * s + 1];
          const float* gp = w.lsg + h * 128 + dg * 32; const float* bp = w.lsb + h * 128 + dg * 32;
#pragma unroll
          for (int q = 0; q < 4; ++q) { const v4u xw = *(const v4u*)(vr + q * 8); const unsigned ww[4] = {xw.x, xw.y, xw.z, xw.w};
#pragma unroll
              for (int e = 0; e < 4; ++e) { const int d = dg * 32 + q * 8 + 2 * e;
                  const float y0 = (bflo(ww[e]) - mean) * rstd * gp[q * 8 + 2 * e] + bp[q * 8 + 2 * e], y1 = (bfhi(ww[e]) - mean) * rstd * gp[q * 8 + 2 * e + 1] + bp[q * 8 + 2 * e + 1];
                  const unsigned pkd = pk2(y0, y1); VT[d * 136 + s] = (bf16)(pkd & 0xffffu); VT[(d + 1) * 136 + s] = (bf16)(pkd >> 16); } } }
        __syncthreads();
        const int nkb = (wave >> 1) + 1;
        f32x4 acc[8];
#pragma unroll
        for (int db = 0; db < 8; ++db) acc[db] = (f32x4){0.f, 0.f, 0.f, 0.f};
        for (int kb = 0; kb < nkb; ++kb) {
            const bf16x8 yf = *(const bf16x8*)(w.wsgu + ((size_t)(h * 128 + wave * 16 + (lane & 15))) * 128 + kb * 32 + (lane >> 4) * 8);
#pragma unroll
            for (int db = 0; db < 8; ++db) { const bf16x8 xf = *(const LAS bf16x8*)(VT + (db * 16 + (lane & 15)) * 136 + kb * 32 + (lane >> 4) * 8);
                acc[db] = __builtin_amdgcn_mfma_f32_16x16x32_bf16(xf, yf, acc[db], 0, 0, 0); }
        }
        { const int t = wave * 16 + (lane & 15); const float bias = w.bsgu[h * 128 + t];
          const bf16* up = P + (size_t)(r0 + t) * PW + 1280 + h * 128 + (lane >> 4) * 4; bf16* yp = Y + (size_t)(r0 + t) * D + 1280 + h * 128 + (lane >> 4) * 4;
#pragma unroll
          for (int db = 0; db < 8; ++db) { const v2u uw = *(const v2u*)(up + db * 16);
              y_store4(Y, w.y8, (size_t)(r0 + t), 1280 + h * 128 + (lane >> 4) * 4 + db * 16, bflo(uw.x) * (acc[db][0] + bias), bfhi(uw.x) * (acc[db][1] + bias), bflo(uw.y) * (acc[db][2] + bias), bfhi(uw.y) * (acc[db][3] + bias)); } (void)yp; }
        __syncthreads();
    }
}

template <int G> __device__ __forceinline__ void pool_group(const bf16* P, bf16* Y, const MixW& w, int r0, int wave, int lane) {
    constexpr int win = 2 << G;
    const int t = wave * 16 + (lane & 15), kq = lane >> 4, pos = (r0 & (SEQ - 1)) + t;
    const bf16* prow = P + (size_t)(r0 + t) * PW + G * 128 + kq * 8;
    const float inv = 1.0f / (float)min(pos + 1, win);
    f32x4 acc[8];
#pragma unroll
    for (int db = 0; db < 8; ++db) acc[db] = (f32x4){0.f, 0.f, 0.f, 0.f};
#pragma unroll 1
    for (int kb = 0; kb < 4; ++kb) {
        float sacc[8], self[8];
#pragma unroll
        for (int e = 0; e < 8; ++e) { sacc[e] = 0.f; self[e] = 0.f; }
#pragma unroll
        for (int j = 0; j < win; ++j) { v4u q = (v4u){0u, 0u, 0u, 0u}; if (pos - j >= 0) q = *(const v4u*)(prow - (size_t)j * PW + kb * 32);
            const unsigned ww[4] = {q.x, q.y, q.z, q.w};
#pragma unroll
            for (int e = 0; e < 4; ++e) { const float lo = bflo(ww[e]), hi = bfhi(ww[e]); sacc[2 * e] += lo; sacc[2 * e + 1] += hi; if (j == 0) { self[2 * e] = lo; self[2 * e + 1] = hi; } } }
        v4u o; o.x = pk2(sacc[0] * inv - self[0], sacc[1] * inv - self[1]); o.y = pk2(sacc[2] * inv - self[2], sacc[3] * inv - self[3]);
        o.z = pk2(sacc[4] * inv - self[4], sacc[5] * inv - self[5]); o.w = pk2(sacc[6] * inv - self[6], sacc[7] * inv - self[7]);
        const bf16x8 yf = __builtin_bit_cast(bf16x8, o);
#pragma unroll
        for (int db = 0; db < 8; ++db) { const bf16x8 xf = *(const bf16x8*)(w.wpoolT + ((size_t)(G * 128 + db * 16 + (lane & 15))) * 128 + kb * 32 + kq * 8);
            acc[db] = __builtin_amdgcn_mfma_f32_16x16x32_bf16(xf, yf, acc[db], 0, 0, 0); }
    }
    bf16* yp = Y + (size_t)(r0 + t) * D + G * 128 + kq * 4;
#pragma unroll
    for (int db = 0; db < 8; ++db) y_store4(Y, w.y8, (size_t)(r0 + t), G * 128 + kq * 4 + db * 16, acc[db][0], acc[db][1], acc[db][2], acc[db][3]);
    (void)yp;
}

__device__ __forceinline__ void conv_wave(LAS unsigned char* lds, const bf16* P, bf16* Y, const MixW& w, int r0, int wave, int lane) {
    LAS unsigned* CO = (LAS unsigned*)(lds + wave * 12288);
    for (int pass = 0; pass < 2; ++pass) {
        const int tb = r0 + wave * 16 + pass * 8, posb = tb & (SEQ - 1);
        unsigned xn[38];
        { const unsigned* xp = (const unsigned*)(P + (size_t)tb * PW + 512) + lane;
#pragma unroll
          for (int i = 0; i < 38; ++i) { xn[i] = 0u; if (posb - 30 + i >= 0) xn[i] = *(xp + (ptrdiff_t)(i - 30) * (PW / 2)); } }
#pragma unroll 1
        for (int slab = 0; slab < 6; ++slab) {
            f32x2 wv[31];
#pragma unroll
            for (int j = 0; j < 31; ++j) wv[j] = *(const f32x2*)(w.cw + j * 768 + slab * 128 + 2 * lane);
            const f32x2 cbv = *(const f32x2*)(w.cb + slab * 128 + 2 * lane);
            f32x2 xs[38];
#pragma unroll
            for (int i = 0; i < 38; ++i) xs[i] = (f32x2){bflo(xn[i]), bfhi(xn[i])};
            if (slab < 5) { const unsigned* xp = (const unsigned*)(P + (size_t)tb * PW + 512 + (slab + 1) * 128) + lane;
#pragma unroll
                for (int i = 0; i < 38; ++i) { xn[i] = 0u; if (posb - 30 + i >= 0) xn[i] = *(xp + (ptrdiff_t)(i - 30) * (PW / 2)); } }
#pragma unroll
            for (int tt = 0; tt < 8; ++tt) { f32x2 o = cbv;
#pragma unroll
                for (int j = 0; j < 31; ++j) o += xs[tt + j] * wv[j];
                CO[tt * 384 + slab * 64 + lane] = pk2(o.x, o.y); }
        }
#pragma unroll
        for (int tt = 0; tt < 8; ++tt) {
            v2u qq[3]; float sa = 0.f, sb = 0.f;
#pragma unroll
            for (int k = 0; k < 3; ++k) { qq[k] = *(const LAS v2u*)(CO + tt * 384 + k * 128 + lane * 2);
                const float a0 = bflo(qq[k].x), a1 = bfhi(qq[k].x), a2 = bflo(qq[k].y), a3 = bfhi(qq[k].y); sa += (a0 + a1) + (a2 + a3); sb += (a0 * a0 + a1 * a1) + (a2 * a2 + a3 * a3); }
            const float mean = wave_sum(sa) * (1.f / 768.f); const float var = fmaxf(wave_sum(sb) * (1.f / 768.f) - mean * mean, 0.f); const float rstd = 1.0f / sqrtf(var + LN_EPS);
            bf16* yp = Y + (size_t)(tb + tt) * D + 512;
#pragma unroll
            for (int k = 0; k < 3; ++k) { const int c = k * 256 + lane * 4; const v2u q = qq[k];
                const f32x4 gg = *(const f32x4*)(w.lcg + c), bb = *(const f32x4*)(w.lcb + c);
                float y[4] = {bflo(q.x), bfhi(q.x), bflo(q.y), bfhi(q.y)};
#pragma unroll
                for (int e = 0; e < 4; ++e) { const float z = (y[e] - mean) * rstd * gg[e] + bb[e]; y[e] = z * __builtin_amdgcn_rcpf(1.0f + __builtin_amdgcn_exp2f(z * -1.4426950408889634f)); }
                y_store4(Y, w.y8, (size_t)(tb + tt), 512 + c, y[0], y[1], y[2], y[3]); } (void)yp; }
    }
}

__device__ __forceinline__ void mixer_phase(LAS unsigned char* lds, const bf16* P, bf16* Y, const MixW& w, int tid, int wave, int lane) {
    for (int u = blockIdx.x; u < M / 128; u += gridDim.x) {
        const int r0 = u * 128;
#ifndef REP_SGU
#define REP_SGU 0
#endif
#ifndef REP_PC
#define REP_PC 0
#endif
        for (int rep = 0; rep <= REP_SGU; ++rep)
        sgu_unit(lds, P, Y, w, r0, tid, wave, lane);
        for (int rep = 0; rep < REP_PC; ++rep) { pool_group<0>(P, Y, w, r0, wave, lane); pool_group<1>(P, Y, w, r0, wave, lane); pool_group<2>(P, Y, w, r0, wave, lane); pool_group<3>(P, Y, w, r0, wave, lane); }
        pool_group<0>(P, Y, w, r0, wave, lane); pool_group<1>(P, Y, w, r0, wave, lane); pool_group<2>(P, Y, w, r0, wave, lane); pool_group<3>(P, Y, w, r0, wave, lane);
#ifndef REP_CV
#define REP_CV 0
#endif
        for (int rep = 0; rep <= REP_CV; ++rep)
        conv_wave(lds, P, Y, w, r0, wave, lane);
        __syncthreads();
    }
}

#define XB_TMO      128
#define XB_XCNT(j)  (256  + 64 * (j))
#define XB_XSUB(j)  (1280 + 64 * (j))
#define XB_XGEN(j)  (2304 + 64 * (j))
#define XB_TOP      3328
#define XB_TOPGEN   3392
#define XCD_BAR_WORDS 3456
#define XB_SPIN_CAP (1u << 18)

__device__ __forceinline__ unsigned xb_ld(unsigned* p)              { return __hip_atomic_load(p, __ATOMIC_RELAXED, __HIP_MEMORY_SCOPE_AGENT); }
__device__ __forceinline__ unsigned xb_add(unsigned* p, unsigned v) { return __hip_atomic_fetch_add(p, v, __ATOMIC_RELAXED, __HIP_MEMORY_SCOPE_AGENT); }
__device__ __forceinline__ unsigned xb_xcc_id() { return (unsigned)__builtin_amdgcn_s_getreg((3 << 11) | 20) & 0xFu; }
#define XB_SPIN(cond, bar) do { unsigned _sp = 0; while (cond) { __builtin_amdgcn_s_sleep(1); \
    if ((++_sp & 255u) == 0u) { if (xb_ld(&(bar)[XB_TMO])) break; if (_sp > XB_SPIN_CAP) { atomicAdd(&(bar)[XB_TMO], 1u); break; } } } } while (0)

struct XcdBarrier {
    unsigned* bar; unsigned x;
    volatile LAS unsigned* st;
};

__device__ __forceinline__ XcdBarrier xcd_barrier_post(unsigned* bar, volatile LAS unsigned* st) {
    XcdBarrier b; b.bar = bar; b.x = xb_xcc_id(); b.st = st;
    if (threadIdx.x == 0) (void)xb_add(&bar[XB_XCNT(b.x)], 1u);
    return b;
}
__device__ __forceinline__ void xcd_barrier_complete(unsigned* bar, unsigned x, unsigned& nloc, unsigned& nx) {
    const unsigned G = gridDim.x * gridDim.y * gridDim.z;
    unsigned sum, cnt, mine, sp = 0u;
    for (;;) {
        sum = 0u; cnt = 0u; mine = 0u;
#pragma unroll
        for (unsigned j = 0; j < 16; ++j) { const unsigned c = xb_ld(&bar[XB_XCNT(j)]); sum += c; cnt += (c > 0u) ? 1u : 0u; mine = (j == x) ? c : mine; }
        if (sum == G) break;
        __builtin_amdgcn_s_sleep(1);
        if ((++sp & 255u) == 0u) { if (xb_ld(&bar[XB_TMO])) break; if (sp > XB_SPIN_CAP) { atomicAdd(&bar[XB_TMO], 1u); break; } }
    }
    nloc = mine > 0u ? mine : 1u; nx = cnt > 0u ? cnt : 1u;
}

__device__ __forceinline__ void xcd_barrier(const XcdBarrier& b) {
    asm volatile("s_waitcnt vmcnt(0)" ::: "memory");
    __syncthreads();
    if (threadIdx.x == 0) {
        unsigned* bar = b.bar;
        __builtin_amdgcn_s_waitcnt(0);
        unsigned nloc = b.st[0], nx = b.st[1];
        if (nloc == 0u) { xcd_barrier_complete(bar, b.x, nloc, nx); b.st[0] = nloc; b.st[1] = nx; }
        const unsigned old = xb_add(&bar[XB_XSUB(b.x)], 1u);
        const unsigned gen = old / nloc;
        if (old + 1u == (gen + 1u) * nloc) {
            __builtin_amdgcn_fence(__ATOMIC_RELEASE, "agent");
            asm volatile("s_waitcnt vmcnt(0)" ::: "memory");
            const unsigned og = xb_add(&bar[XB_TOP], 1u);
            const unsigned tg = og / nx;
            if (og + 1u == (tg + 1u) * nx) xb_add(&bar[XB_TOPGEN], 1u);
            else XB_SPIN(xb_ld(&bar[XB_TOPGEN]) == tg, bar);
            __builtin_amdgcn_fence(__ATOMIC_ACQUIRE, "agent");
            xb_add(&bar[XB_XGEN(b.x)], 1u);
            asm volatile("s_waitcnt vmcnt(0)" ::: "memory");
        } else {
            XB_SPIN(xb_ld(&bar[XB_XGEN(b.x)]) == gen, bar);
            __builtin_amdgcn_fence(__ATOMIC_ACQUIRE, "agent");
            asm volatile("s_waitcnt vmcnt(0)" ::: "memory");
        }
    }
    __syncthreads();
}

#define AS4 __attribute__((address_space(4)))
#define PHASE_BEGIN const AS4 Args* ap = (const AS4 Args*)__builtin_amdgcn_kernarg_segment_ptr(); asm volatile("" : "+s"(ap)); \
    int tid = threadIdx.x; asm volatile("" : "+v"(tid)); const int lane = tid & 63, wave = __builtin_amdgcn_readfirstlane(tid >> 6); (void)lane; (void)wave; \
    unsigned char* ws = ap->ws; (void)ws;
#ifdef DBG_TS
#define DBG_STAMP(i) do { if (blockIdx.x == 0 && threadIdx.x == 0) { const AS4 Args* ap_ = (const AS4 Args*)__builtin_amdgcn_kernarg_segment_ptr(); ((unsigned long long*)(ap_->ws + 3 * MiB))[(i)] = __builtin_amdgcn_s_memrealtime(); } } while (0)
#else
#define DBG_STAMP(i) do { } while (0)
#endif
#define RSYNC() do { xcd_barrier(bar); } while (0)
#ifndef REP_PRO
#define REP_PRO 0
#endif
#ifndef REP_MIX
#define REP_MIX 0
#endif
#ifndef REP_LN
#define REP_LN 0
#endif
#ifndef REP_FF1
#define REP_FF1 0
#endif
#ifndef REP_INP
#define REP_INP 0
#endif
#ifndef REP_OUT0
#define REP_OUT0 0
#endif
template <int L> __device__ __forceinline__ void layer_phases(LAS unsigned char* lds, const XcdBarrier& bar, const int lo, const int hi) {
#define IN(k) (lo <= (k) && (k) < hi)
#define SEAM(k) do { if (IN(k) && IN((k) + 1)) { xcd_barrier(bar); } } while (0)
    constexpr int pb = 2 + 7 * L;
    if (IN(pb)) { PHASE_BEGIN
        pg8::Gemm g{(const bf16*)(ws + WS_H), (const bf16*)(ws + WS_WIN) + (size_t)L * NIN * D, M, NIN, D}; pg8::StaticOrder S; S.init(M, NIN, (int)gridDim.x, (int)blockIdx.x);
        pg8::EpiInProj E{(bf16*)(ws + WS_P)}; for (int rep = 0; rep <= REP_INP; ++rep) { if (rep) RSYNC(); pg8::gemm_phase<pg8::EpiInProj, pg8::StaticOrder, true, true>(lds, g, S, E); } }
    SEAM(pb);
    if (IN(pb + 1)) { PHASE_BEGIN
        MixW w; w.y8 = (L == FP8_OUT_LAYER); w.wpoolT = (const bf16*)(ws + WS_WPOOL) + (size_t)L * 4 * 128 * 128; w.wsgu = (const bf16*)(ws + WS_WSGU) + (size_t)L * 6 * 128 * 128;
        w.bsgu = ap->in[12] + L * 768; w.lsg = ap->in[13] + L * 768; w.lsb = ap->in[14] + L * 768; w.cw = ap->in[7] + L * 31 * 768; w.cb = ap->in[8] + L * 768; w.lcg = ap->in[9] + L * 768; w.lcb = ap->in[10] + L * 768;
        for (int rep = 0; rep <= REP_MIX; ++rep) { if (rep) RSYNC(); mixer_phase(lds, (const bf16*)(ws + WS_P), (bf16*)(ws + WS_Y), w, tid, wave, lane); } }
    SEAM(pb + 1);
    if (IN(pb + 2)) { PHASE_BEGIN
        pg8::Gemm g{(const bf16*)(ws + WS_Y), (const bf16*)(ws + WS_WOUT) + (size_t)L * D * D, M, D, L == FP8_OUT_LAYER ? D / 2 : D}; pg8::StaticOrder S; S.init(M, D, (int)gridDim.x, (int)blockIdx.x);
        float* X = ap->out; const float* gate = (const float*)(ws + WS_MOD) + (size_t)L * NB * NMOD + 2 * D;
        bf16* R = (bf16*)(ws + WS_R); (void)X;
        if (L == 0) { pg8::EpiResid<true, false> E{ap->in[0], nullptr, nullptr, R, gate, nullptr, nullptr, nullptr, (float*)(ws + WS_PART), ALPHA, 1.0f}; for (int rep = 0; rep <= REP_OUT0; ++rep) { if (rep) RSYNC(); pg8::gemm_phase<pg8::EpiResid<true, false>, pg8::StaticOrder, true, true>(lds, g, S, E); } }
        else { pg8::EpiResid<false, false> E{nullptr, R, nullptr, R, gate, (const float*)(ws + WS_RSTAT), ap->in[20], ap->in[21], (float*)(ws + WS_PART), ALPHA, L == FP8_OUT_LAYER ? 1.0f / 64.0f : 1.0f}; pg8::gemm_phase<pg8::EpiResid<false, false>, pg8::StaticOrder, true, true, L == FP8_OUT_LAYER>(lds, g, S, E); } }
    SEAM(pb + 2);
    if (IN(pb + 3)) { PHASE_BEGIN
        float* X = ap->out; const float* modl = (const float*)(ws + WS_MOD) + (size_t)L * NB * NMOD;
        (void)X; lnmod_phase<true, true, false, true>(ws + WS_R, nullptr, (bf16*)(ws + WS_H), ap->in[16] + L * D, ap->in[17] + L * D, modl + 3 * D, modl + 4 * D, (const float*)(ws + WS_PART), (float*)(ws + WS_RSTAT), wave, lane); }
    SEAM(pb + 3);
    if (IN(pb + 4)) { PHASE_BEGIN
        pg8::Gemm g{(const bf16*)(ws + WS_H), (const bf16*)(ws + WS_WFF1) + (size_t)L * DFF * D, M, DFF, D}; pg8::StaticOrder S; S.init(M, DFF, (int)gridDim.x, (int)blockIdx.x);
#ifdef STAG_FF1
        { const unsigned long long t0 = __builtin_amdgcn_s_memrealtime(); const unsigned long long dl = (unsigned long long)(((blockIdx.x >> 3) & (STAG_N - 1)) * STAG_FF1);
          while (__builtin_amdgcn_s_memrealtime() - t0 < dl) __builtin_amdgcn_s_sleep(16); }
#endif
#ifdef PROBE_NULL
        { pg8::EpiNull E0{(bf16*)(ws + WS_BIG)}; pg8::gemm_phase<pg8::EpiNull, pg8::StaticOrder, true, true>(lds, g, S, E0); RSYNC(); }
#endif
#ifdef PROBE_CLK
        unsigned long long c0_ = 0, r0_ = 0; if (L == 0) { c0_ = __builtin_readcyclecounter(); r0_ = __builtin_amdgcn_s_memrealtime(); }
#endif
        pg8::EpiRelu2<false> E{(bf16*)(ws + WS_BIG)}; for (int rep = 0; rep <= REP_FF1; ++rep) { if (rep) RSYNC(); pg8::gemm_phase<pg8::EpiRelu2<false>, pg8::StaticOrder, true, true>(lds, g, S, E); }
#ifdef PROBE_CLK
        if (L == 0 && blockIdx.x == 0 && threadIdx.x == 0) { const unsigned long long c1_ = __builtin_readcyclecounter(), r1_ = __builtin_amdgcn_s_memrealtime();
            ((float*)(ws + 3 * MiB))[0] = (float)(c1_ - c0_) / (float)(r1_ - r0_); ((float*)(ws + 3 * MiB))[1] = (float)(r1_ - r0_) * 0.01f; }
#endif
        }
    SEAM(pb + 4);
    if (IN(pb + 5)) { PHASE_BEGIN
        pg8::Gemm g{(const bf16*)(ws + WS_BIG), (const bf16*)(ws + WS_WFF2) + (size_t)L * D * DFF, M, D, DFF}; pg8::StaticOrder S; S.init(M, D, (int)gridDim.x, (int)blockIdx.x);
        float* X = ap->out; bf16* R = (bf16*)(ws + WS_R);
        (void)X; pg8::EpiResid<false, false> E{nullptr, R, nullptr, R, (const float*)(ws + WS_MOD) + (size_t)L * NB * NMOD + 5 * D, (const float*)(ws + WS_RSTAT), ap->in[16] + L * D, ap->in[17] + L * D, (float*)(ws + WS_PART), ALPHA, 1.0f};
        pg8::gemm_phase<pg8::EpiResid<false, false>, pg8::StaticOrder, true, true>(lds, g, S, E); }
    SEAM(pb + 5);
    if (IN(pb + 6)) { PHASE_BEGIN
        float* X = ap->out; const float* mod1 = (const float*)(ws + WS_MOD) + (size_t)NB * NMOD;
        if (L == 0) lnmod_phase<true, true, false, true>(ws + WS_R, nullptr, (bf16*)(ws + WS_H), ap->in[20], ap->in[21], mod1 + 0 * D, mod1 + 1 * D, (const float*)(ws + WS_PART), (float*)(ws + WS_RSTAT), wave, lane);
        else lnmod_phase<true, true, true, false>(ws + WS_R, X, nullptr, ap->in[20] + D, ap->in[21] + D, nullptr, nullptr, (const float*)(ws + WS_PART), nullptr, wave, lane); }
    SEAM(pb + 6);
}
__global__ void __launch_bounds__(NTHR, 2) fwd_kernel(Args a_unused) {
    extern __shared__ __attribute__((aligned(16))) unsigned char lds_raw[];
    LAS unsigned char* lds = (LAS unsigned char*)lds_raw;
    cg::grid_group grid = cg::this_grid();
    int lo, hi; XcdBarrier bar; { const AS4 Args* ap0 = (const AS4 Args*)__builtin_amdgcn_kernarg_segment_ptr(); lo = ap0->ph_lo; hi = ap0->ph_hi;
        volatile LAS unsigned* stw = (volatile LAS unsigned*)(lds + LDS_BARW); if (threadIdx.x == 0) { stw[0] = 0u; stw[1] = 0u; } __syncthreads();
        bar = xcd_barrier_post((unsigned*)(ap0->ws + WS_BAR), stw); }
    if (lo < 0) grid.sync();
    DBG_STAMP(0);
    if (IN(0)) { PHASE_BEGIN for (int rep = 0; rep <= REP_PRO; ++rep) { if (rep) RSYNC(); prologue_phase(lds, ap, tid, wave, lane); } }
    SEAM(0);
    if (IN(1)) { PHASE_BEGIN for (int rep = 0; rep <= REP_LN; ++rep) { if (rep) RSYNC();
        lnmod_phase<false, false, false, true>(ap->in[0], nullptr, (bf16*)(ws + WS_H), nullptr, nullptr, (const float*)(ws + WS_MOD) + 0 * D, (const float*)(ws + WS_MOD) + 1 * D, nullptr, nullptr, wave, lane); } }
    SEAM(1);
#ifdef DBG_LAST
    if (lo >= 100) { PHASE_BEGIN
        const int which = lo - 100; const bf16* src = which == 0 ? (const bf16*)(ws + WS_H) : which == 1 ? (const bf16*)(ws + WS_P) + DBG_COL : which == 2 ? (const bf16*)(ws + WS_Y) : (const bf16*)(ws + WS_BIG) + DBG_COL;
        const int pitch = which == 0 ? D : which == 1 ? PW : which == 2 ? D : DFF; float* X = ap->out;
        for (size_t i = (size_t)blockIdx.x * NTHR + tid; i < (size_t)M * D; i += (size_t)gridDim.x * NTHR) { const size_t m = i >> 11, c = i & 2047; float v = __uint_as_float((unsigned)src[m * pitch + c] << 16); v = (!(fabsf(v) < 1e30f)) ? ((DBG_COND) ? 1000.f : 1.f) : 0.f; X[i] = v; }
        return; }
#endif
#ifdef PROBE_SYNCS
    for (int i = 0; i < PROBE_SYNCS; ++i) RSYNC();
#endif
    layer_phases<0>(lds, bar, lo, hi);
    layer_phases<1>(lds, bar, lo, hi);
#ifdef PROBE_CLK
    if (blockIdx.x == 0 && threadIdx.x == 0) { const AS4 Args* ap_ = (const AS4 Args*)__builtin_amdgcn_kernarg_segment_ptr(); const float* pr = (const float*)(ap_->ws + 3 * MiB);
        asm volatile("s_waitcnt vmcnt(0)" ::: "memory"); ap_->out[0] = rintf(pr[0] * PROBE_CLK) ; }
#endif
#ifdef DBG_TS
    DBG_STAMP(16);
    if (blockIdx.x == 0 && threadIdx.x == 0) { const AS4 Args* ap_ = (const AS4 Args*)__builtin_amdgcn_kernarg_segment_ptr(); const unsigned long long* ts = (const unsigned long long*)(ap_->ws + 3 * MiB);
        asm volatile("s_waitcnt vmcnt(0)" ::: "memory");
        float A = 0.f, B = 0.f;
        for (int k = 0; k < 16; ++k) { const float d = (float)(ts[k + 1] - ts[k]) * 0.01f; if ((DBG_TA >> k) & 1) A += d; if ((DBG_TB >> k) & 1) B += d; }
        ap_->out[0] = A / DBG_DA; ap_->out[1] = B / DBG_DB; }
#endif
#undef IN
#undef SEAM
}
constexpr int NPHASES = 16;
#ifndef MK_N_LAUNCHES
#define MK_N_LAUNCHES 1
#endif

extern "C" void kernel_launch(void* const* d_in, const int* in_sizes, int n_in, void* d_out, int out_size, void* d_ws, size_t ws_size, hipStream_t stream) {
    static int grid = 0;
    if (grid == 0) {
        if (n_in != 22 || out_size != M * D || ws_size < WS_END) { fprintf(stderr, "kernel_launch: unexpected shapes (n_in %d, out %d, ws %zu < %zu)\n", n_in, out_size, ws_size, (size_t)WS_END); grid = -1; return; }
        int dev = 0, cus = 0, per_cu = 0;
        hipGetDevice(&dev); hipDeviceGetAttribute(&cus, hipDeviceAttributeMultiprocessorCount, dev);
        if (hipFuncSetAttribute((const void*)fwd_kernel, hipFuncAttributeMaxDynamicSharedMemorySize, LDS_BYTES) != hipSuccess) { fprintf(stderr, "kernel_launch: hipFuncSetAttribute failed\n"); grid = -1; return; }
        if (hipOccupancyMaxActiveBlocksPerMultiprocessor(&per_cu, (const void*)fwd_kernel, NTHR, LDS_BYTES) != hipSuccess || per_cu < 1) { fprintf(stderr, "kernel_launch: occupancy query says %d\n", per_cu); per_cu = 1; (void)hipGetLastError(); }
        grid = cus * per_cu;
    }
    if (grid < 0) return;
    if (hipMemsetAsync((char*)d_ws + WS_BAR, 0, BAR_BYTES, stream) != hipSuccess) { fprintf(stderr, "kernel_launch: hipMemsetAsync failed\n"); return; }
    Args a{};
    for (int i = 0; i < 22; ++i) a.in[i] = (const float*)d_in[i];
    a.out = (float*)d_out; a.ws = (unsigned char*)d_ws;
    if (MK_N_LAUNCHES == 1) {
        a.ph_lo = 0; a.ph_hi = NPHASES;
        void* args[] = {&a};
        hipError_t e = hipLaunchCooperativeKernel((const void*)fwd_kernel, dim3(grid), dim3(NTHR), args, LDS_BYTES, stream);
        if (e != hipSuccess) fprintf(stderr, "kernel_launch: cooperative launch failed: %s (grid %d)\n", hipGetErrorString(e), grid);
    } else {
#ifdef DBG_LAST
        for (int p = 0; p <= DBG_LAST; ++p) { a.ph_lo = p; a.ph_hi = p + 1; hipLaunchKernelGGL(fwd_kernel, dim3(grid), dim3(NTHR), LDS_BYTES, stream, a); }
        a.ph_lo = 100 + DBG_WHICH; a.ph_hi = 0; hipLaunchKernelGGL(fwd_kernel, dim3(grid), dim3(NTHR), LDS_BYTES, stream, a);
#else
        for (int p = 0; p < NPHASES; ++p) { a.ph_lo = p; a.ph_hi = p + 1; hipLaunchKernelGGL(fwd_kernel, dim3(grid), dim3(NTHR), LDS_BYTES, stream, a); }
#endif
    }
}
```

```cpp
#include <hip/hip_runtime.h>
#include <hip/hip_cooperative_groups.h>
#include <cstdio>
#include <cstdint>
namespace cg = cooperative_groups;
namespace pg8 {
#define PG8_LAS __attribute__((address_space(3)))
typedef unsigned short bf16_t;
typedef short bf16x8 __attribute__((ext_vector_type(8)));
typedef float f32x4 __attribute__((ext_vector_type(4)));
typedef unsigned u32x4 __attribute__((ext_vector_type(4)));
constexpr int BM = 256, BK = 64, HALF = 128, HTB = HALF * BK * 2  , STAGE_BYTES = 8 * HTB, NXCD = 8, WGM = 8;

__host__ __device__ __forceinline__ int lds_byte(int r, int c) { const int st = (r >> 4) * 2 + (c >> 5), rr = r & 15, cc = c & 31, ob = rr * 64 + cc * 2; return st * 1024 + (ob ^ (((ob >> 9) & 1) << 5)); }
__host__ __device__ __forceinline__ void stage_rc(int b, int& R, int& C) { const int st = b / 1024, sb = b % 1024, swz = sb ^ (((sb >> 9) & 1) << 5); R = (st >> 1) * 16 + swz / 64; C = (st & 1) * 32 + (swz % 64) / 2; }
__host__ __device__ __forceinline__ int perm32(int rho) { const int n = rho >> 4, i = rho & 15; return 8 * (i >> 2) + 4 * n + (i & 3); }

struct Unit { int pm, pn; };
struct Gemm { const bf16_t* A; const bf16_t* Bt; int M, N, K; };

struct StaticOrder {
    int nM, nN, nwg, G, c;
    __host__ __device__ void init(int M, int N, int G_, int c_) { nM = M / BM; nN = N / BM; nwg = nM * nN; G = G_; c = c_; }
    __host__ __device__ bool next(int i, Unit& u) const {
        const long L = (long)i * G + c; if (L >= nwg) return false;
        int wgid = (int)L; { const int q = nwg / NXCD, r = nwg % NXCD, xcd = wgid % NXCD, off = wgid / NXCD; wgid = (xcd < r ? xcd * (q + 1) : r * (q + 1) + (xcd - r) * q) + off; }
        const int nig = WGM * nN, gid = wgid / nig, fm = gid * WGM, gsz = (nM - fm) < WGM ? (nM - fm) : WGM;
        u.pm = fm + ((wgid % nig) % gsz); u.pn = (wgid % nig) / gsz; return true;
    }
    __device__ __forceinline__ void a_ready(const Unit&) const {}
    __device__ __forceinline__ void done(const Unit&) const {}
};

typedef __bf16 bf16x2_cv __attribute__((ext_vector_type(2)));
typedef float f32x2_cv __attribute__((ext_vector_type(2)));
__device__ __forceinline__ unsigned cvt_pk_bf16(float lo, float hi) { const f32x2_cv f = {lo, hi}; const bf16x2_cv b = __builtin_convertvector(f, bf16x2_cv); return __builtin_bit_cast(unsigned, b); }
typedef float f32x2 __attribute__((ext_vector_type(2)));
__device__ __forceinline__ f32x2 gelu_pk(f32x2 v) {
    const f32x2 av = __builtin_elementwise_abs(v), d = av * 0.2316418882f + 1.0f;
    f32x2 t; t.x = __builtin_amdgcn_rcpf(d.x); t.y = __builtin_amdgcn_rcpf(d.y);
    f32x2 q = t * 0.5307027145f + (-0.7265760135f); q = q * t + 0.7107068705f; q = q * t + (-0.142248368f); q = q * t + 0.127414796f; q = q * t;
    const f32x2 s = (v * v) * (-0.72134752044f);
    f32x2 e; e.x = __builtin_amdgcn_exp2f(s.x); e.y = __builtin_amdgcn_exp2f(s.y);
    const f32x2 m = v * (q * e), r = v - m;
    f32x2 o; o.x = v.x < 0.f ? m.x : r.x; o.y = v.y < 0.f ? m.y : r.y; return o;
}

constexpr int PW = 2816;
struct EpiInProj {
    static constexpr bool PERM = true, AFTER_DRAIN = false;
    bf16_t* P;
    __device__ __forceinline__ void operator()(const f32x4 (&acc)[2][2][4][2], const Unit& u, int wr, int wc, int fr, int fq) const {
        const int row0 = u.pm * BM + wr * 64 + fr; const int pn = u.pn;
        if (pn >= 2 && pn < 8) {
            const int col0 = 512 + (pn - 2) * 128 + wc * 32 + 8 * fq;
#pragma unroll
            for (int ai = 0; ai < 2; ++ai)
#pragma unroll
                for (int m = 0; m < 4; ++m) { bf16_t* rowp = P + (size_t)(row0 + ai * HALF + m * 16) * PW + col0;
                    float o[8];
#pragma unroll
                    for (int n = 0; n < 2; ++n)
#pragma unroll
                        for (int j = 0; j < 4; ++j) { const float v = acc[ai][0][m][n][j], g = acc[ai][1][m][n][j];
                            o[n * 4 + j] = v * __builtin_amdgcn_rcpf(1.0f + __builtin_amdgcn_exp2f(g * -1.4426950408889634f)); }
                    u32x4 w; w.x = cvt_pk_bf16(o[0], o[1]); w.y = cvt_pk_bf16(o[2], o[3]); w.z = cvt_pk_bf16(o[4], o[5]); w.w = cvt_pk_bf16(o[6], o[7]);
                    *(u32x4*)rowp = w; }
        } else {
            const int colt = pn < 2 ? pn * 256 : 1280 + (pn - 8) * 256; const bool act = pn >= 8;
            const int col0 = colt + wc * 32 + 8 * fq;
#pragma unroll
            for (int ai = 0; ai < 2; ++ai)
#pragma unroll
                for (int m = 0; m < 4; ++m) { bf16_t* rowp = P + (size_t)(row0 + ai * HALF + m * 16) * PW + col0;
#pragma unroll
                    for (int bj = 0; bj < 2; ++bj) { f32x4 v0 = acc[ai][bj][m][0], v1 = acc[ai][bj][m][1];
                        if (act) { f32x2 a = gelu_pk((f32x2){v0[0], v0[1]}), b = gelu_pk((f32x2){v0[2], v0[3]}), c = gelu_pk((f32x2){v1[0], v1[1]}), d = gelu_pk((f32x2){v1[2], v1[3]});
                            v0 = (f32x4){a.x, a.y, b.x, b.y}; v1 = (f32x4){c.x, c.y, d.x, d.y}; }
                        u32x4 w; w.x = cvt_pk_bf16(v0[0], v0[1]); w.y = cvt_pk_bf16(v0[2], v0[3]); w.z = cvt_pk_bf16(v1[0], v1[1]); w.w = cvt_pk_bf16(v1[2], v1[3]);
                        *(u32x4*)(rowp + bj * HALF) = w; } }
        }
    }
};
typedef _Float16 h16x2_cv __attribute__((ext_vector_type(2)));
__device__ __forceinline__ unsigned pk_h2(float lo, float hi) { const f32x2_cv f = {lo, hi}; const h16x2_cv h = __builtin_convertvector(f, h16x2_cv); return __builtin_bit_cast(unsigned, h); }
__device__ __forceinline__ f32x2_cv up_h2(unsigned w) { const h16x2_cv h = __builtin_bit_cast(h16x2_cv, w); return __builtin_convertvector(h, f32x2_cv); }
template <bool RAW, bool LAST> struct EpiResid {
    static constexpr bool PERM = true, AFTER_DRAIN = false;
    const float* xin_f; const bf16_t* xin_h; float* xout_f; bf16_t* xout_h; const float* gate; const float* rstat; const float* lng; const float* lnb; float* part; float alpha; float accs;
    __device__ __forceinline__ void operator()(const f32x4 (&acc)[2][2][4][2], const Unit& u, int wr, int wc, int fr, int fq) const {
        const int row0 = u.pm * BM + wr * 64 + fr, col0 = u.pn * BM + wc * 32 + 8 * fq;
        const float* gp = gate + (size_t)(u.pm >> 3) * 12288 + col0;
        f32x4 gv[2][2], gl[2][2], bl[2][2];
#pragma unroll
        for (int bj = 0; bj < 2; ++bj)
#pragma unroll
            for (int n = 0; n < 2; ++n) { gv[bj][n] = *(const f32x4*)(gp + bj * HALF + n * 4) * accs;
                if (!RAW) { gl[bj][n] = *(const f32x4*)(lng + col0 + bj * HALF + n * 4); bl[bj][n] = *(const f32x4*)(lnb + col0 + bj * HALF + n * 4); } }
#pragma unroll
        for (int ai = 0; ai < 2; ++ai)
#pragma unroll
            for (int m = 0; m < 4; ++m) { const int row = row0 + ai * HALF + m * 16; const size_t off = (size_t)row * 2048 + col0;
                float mean = 0.f, rstd = 1.f; if (!RAW) { const f32x2 st = *(const f32x2*)(rstat + 2 * (size_t)row); mean = st.x; rstd = st.y; }
                float s = 0.f, q = 0.f;
#pragma unroll
                for (int bj = 0; bj < 2; ++bj) { f32x4 x0, x1;
                    if (RAW) { x0 = *(const f32x4*)(xin_f + off + bj * HALF); x1 = *(const f32x4*)(xin_f + off + bj * HALF + 4); }
                    else { const u32x4 w = *(const u32x4*)(xin_h + off + bj * HALF);
                        { const f32x2_cv a = up_h2(w.x), b = up_h2(w.y), c = up_h2(w.z), d = up_h2(w.w); x0 = (f32x4){a.x, a.y, b.x, b.y}; x1 = (f32x4){c.x, c.y, d.x, d.y}; }
                        x0 = (x0 - mean) * rstd * gl[bj][0] + bl[bj][0]; x1 = (x1 - mean) * rstd * gl[bj][1] + bl[bj][1]; }
                    f32x4 o0 = x0 * alpha + gv[bj][0] * acc[ai][bj][m][0], o1 = x1 * alpha + gv[bj][1] * acc[ai][bj][m][1];
                    if (LAST) { *(f32x4*)(xout_f + off + bj * HALF) = o0; *(f32x4*)(xout_f + off + bj * HALF + 4) = o1; }
                    else { u32x4 w; w.x = pk_h2(o0[0], o0[1]); w.y = pk_h2(o0[2], o0[3]); w.z = pk_h2(o1[0], o1[1]); w.w = pk_h2(o1[2], o1[3]);
                        *(u32x4*)(xout_h + off + bj * HALF) = w;
                        const f32x2_cv a = up_h2(w.x), b = up_h2(w.y), c = up_h2(w.z), d = up_h2(w.w); o0 = (f32x4){a.x, a.y, b.x, b.y}; o1 = (f32x4){c.x, c.y, d.x, d.y}; }
                    s += ((o0[0] + o0[1]) + (o0[2] + o0[3])) + ((o1[0] + o1[1]) + (o1[2] + o1[3]));
                    q += ((o0[0] * o0[0] + o0[1] * o0[1]) + (o0[2] * o0[2] + o0[3] * o0[3])) + ((o1[0] * o1[0] + o1[1] * o1[1]) + (o1[2] * o1[2] + o1[3] * o1[3])); }
                s += __shfl_xor(s, 16); s += __shfl_xor(s, 32); q += __shfl_xor(q, 16); q += __shfl_xor(q, 32);
                if (fq == 0) *(f32x2*)(part + ((size_t)row * 32 + u.pn * 4 + wc) * 2) = (f32x2){s, q};
                asm volatile("" ::: "memory"); }
    }
};
template <bool F8> struct EpiRelu2 {
    static constexpr bool PERM = true, AFTER_DRAIN = false;
    bf16_t* O;
    __device__ __forceinline__ void operator()(const f32x4 (&acc)[2][2][4][2], const Unit& u, int wr, int wc, int fr, int fq) const {
        const int row0 = u.pm * BM + wr * 64 + fr, col0 = u.pn * BM + wc * 32 + 8 * fq;
#pragma unroll
        for (int ai = 0; ai < 2; ++ai)
#pragma unroll
            for (int m = 0; m < 4; ++m) {
#pragma unroll
                for (int bj = 0; bj < 2; ++bj) { f32x4 v0 = acc[ai][bj][m][0], v1 = acc[ai][bj][m][1];
#pragma unroll
                    for (int j = 0; j < 4; ++j) { const float a = fmaxf(v0[j], 0.f), b = fmaxf(v1[j], 0.f); v0[j] = a * a; v1[j] = b * b; }
                    if (F8) { unsigned char* rowp = (unsigned char*)O + (size_t)(row0 + ai * HALF + m * 16) * 8192 + col0 + bj * HALF;
                        int w0 = 0, w1 = 0; w0 = __builtin_amdgcn_cvt_pk_fp8_f32(v0[0], v0[1], w0, false); w0 = __builtin_amdgcn_cvt_pk_fp8_f32(v0[2], v0[3], w0, true);
                        w1 = __builtin_amdgcn_cvt_pk_fp8_f32(v1[0], v1[1], w1, false); w1 = __builtin_amdgcn_cvt_pk_fp8_f32(v1[2], v1[3], w1, true);
                        typedef unsigned u32x2_f8 __attribute__((ext_vector_type(2))); *(u32x2_f8*)rowp = (u32x2_f8){(unsigned)w0, (unsigned)w1}; }
                    else { bf16_t* rowp = O + (size_t)(row0 + ai * HALF + m * 16) * 8192 + col0;
                        u32x4 w; w.x = cvt_pk_bf16(v0[0], v0[1]); w.y = cvt_pk_bf16(v0[2], v0[3]); w.z = cvt_pk_bf16(v1[0], v1[1]); w.w = cvt_pk_bf16(v1[2], v1[3]);
                        *(u32x4*)(rowp + bj * HALF) = w; } } }
    }
};

struct EpiNull {
    static constexpr bool PERM = true, AFTER_DRAIN = false;
    bf16_t* O;
    __device__ __forceinline__ void operator()(const f32x4 (&acc)[2][2][4][2], const Unit& u, int wr, int wc, int fr, int fq) const {
        f32x4 s = (f32x4){0.f, 0.f, 0.f, 0.f};
#pragma unroll
        for (int ai = 0; ai < 2; ++ai)
#pragma unroll
            for (int bj = 0; bj < 2; ++bj)
#pragma unroll
                for (int m = 0; m < 4; ++m)
#pragma unroll
                    for (int n = 0; n < 2; ++n) s += acc[ai][bj][m][n];
        if (s[0] + s[1] + s[2] + s[3] == 1234.56789f) O[(size_t)u.pm * 7 + fr] = 1;
    }
};
typedef int i32x4_f8 __attribute__((ext_vector_type(4)));
typedef int i32x8_f8 __attribute__((ext_vector_type(8)));
template <class Epi, class Sched, bool ALIGN_EPI = false, bool SP2 = false, bool F8 = false>
__device__ __forceinline__ void gemm_phase(PG8_LAS unsigned char* lds, const Gemm g, const Sched& S, const Epi& E) {
    int tid_ = threadIdx.x; asm volatile("" : "+v"(tid_)); const int tid = tid_, wid = __builtin_amdgcn_readfirstlane(tid >> 6), lane = tid & 63, wr = wid >> 2, wc = wid & 3, fr = lane & 15, fq = lane >> 4;
    const int K = g.K, nt = K / BK;
    unsigned voffA[2], voffB[2];
#pragma unroll
    for (int i = 0; i < 2; ++i) { int R, C; stage_rc(tid * 16 + i * 8192, R, C); const int Rb = Epi::PERM ? ((R & ~31) + perm32(R & 31)) : R;
        voffA[i] = (unsigned)(R * K + C) * 2u; voffB[i] = (unsigned)(Rb * K + C) * 2u; }
    const size_t kstep = (size_t)(BK * 2);
    const size_t hstep = (size_t)HALF * K * 2;
    const size_t tstep = 2 * hstep;
    const unsigned ldsw = (unsigned)wid * 1024u;
    const int aoff = lds_byte(wr * 64 + fr, fq * 8), boff = lds_byte(wc * 32 + fr, fq * 8);
#define PG8_SA(b, h) (((b) * 2 + (h)) * HTB)
#define PG8_SB(b, h) ((4 + (b) * 2 + (h)) * HTB)
#define PG8_STAGE(bufoff, gbase, voff) do { _Pragma("unroll") for (int _i = 0; _i < 2; ++_i) \
        __builtin_amdgcn_global_load_lds((const unsigned*)((const char*)(gbase) + (voff)[_i]), (PG8_LAS unsigned*)(lds + (bufoff) + ldsw + _i * 8192), 16, 0, 0); } while (0)
#define PG8_LDA(dst, b, h) do { if constexpr (F8) { _Pragma("unroll") for (int m = 0; m < 4; ++m) { const i32x4_f8 l0_ = *(const PG8_LAS i32x4_f8*)(lds + PG8_SA(b, h) + aoff + m * 2048), l1_ = *(const PG8_LAS i32x4_f8*)(lds + PG8_SA(b, h) + aoff + m * 2048 + 1024); \
        dst##8[m] = __builtin_shufflevector(l0_, l1_, 0, 1, 2, 3, 4, 5, 6, 7); } } else { _Pragma("unroll") for (int m = 0; m < 4; ++m) _Pragma("unroll") for (int k = 0; k < 2; ++k) dst[m][k] = *(const PG8_LAS bf16x8*)(lds + PG8_SA(b, h) + aoff + m * 2048 + k * 1024); } } while (0)
#define PG8_LDB(dst, b, h) do { if constexpr (F8) { _Pragma("unroll") for (int n = 0; n < 2; ++n) { const i32x4_f8 l0_ = *(const PG8_LAS i32x4_f8*)(lds + PG8_SB(b, h) + boff + n * 2048), l1_ = *(const PG8_LAS i32x4_f8*)(lds + PG8_SB(b, h) + boff + n * 2048 + 1024); \
        dst##8[n] = __builtin_shufflevector(l0_, l1_, 0, 1, 2, 3, 4, 5, 6, 7); } } else { _Pragma("unroll") for (int n = 0; n < 2; ++n) _Pragma("unroll") for (int k = 0; k < 2; ++k) dst[n][k] = *(const PG8_LAS bf16x8*)(lds + PG8_SB(b, h) + boff + n * 2048 + k * 1024); } } while (0)
#define PG8_MMA(ai, bj, At, Bt) do { __builtin_amdgcn_s_setprio(1); if constexpr (F8) { _Pragma("unroll") for (int m = 0; m < 4; ++m) _Pragma("unroll") for (int n = 0; n < 2; ++n) \
        asm volatile("v_mfma_scale_f32_16x16x128_f8f6f4 %0, %1, %2, %0, %3, %3 op_sel_hi:[0,0,0]" : "+v"(acc[ai][bj][m][n]) : "v"(Bt##8[n]), "v"(At##8[m]), "v"(sc1_)); } else { \
        _Pragma("unroll") for (int m = 0; m < 4; ++m) _Pragma("unroll") for (int n = 0; n < 2; ++n) _Pragma("unroll") for (int k = 0; k < 2; ++k) \
        acc[ai][bj][m][n] = __builtin_amdgcn_mfma_f32_16x16x32_bf16(Bt[n][k], At[m][k], acc[ai][bj][m][n], 0, 0, 0); } __builtin_amdgcn_s_setprio(0); } while (0)
#define PG8_WAIT_V(n) asm volatile("s_waitcnt vmcnt(" #n ")" ::: "memory")
#define PG8_WAIT_L(n) asm volatile("s_waitcnt lgkmcnt(" #n ")" ::: "memory")
#define PG8_BAR __builtin_amdgcn_s_barrier()
#define PG8_SCHED __builtin_amdgcn_sched_barrier(0)
    Unit cur, nxt; int ui = 0;
    if (!S.next(0, cur)) return;
    f32x4 acc[2][2][4][2];
#pragma unroll
    for (int a = 0; a < 2; ++a)
#pragma unroll
        for (int b = 0; b < 2; ++b)
#pragma unroll
            for (int m = 0; m < 4; ++m)
#pragma unroll
                for (int n = 0; n < 2; ++n) acc[a][b][m][n] = (f32x4){0.f, 0.f, 0.f, 0.f};
    int sc1_ = 0x7f7f7f7f; asm volatile("" : "+v"(sc1_));
    bf16x8 At[4][2], B0[2][2], B1[2][2]; i32x8_f8 At8[4], B08[2], B18[2]; (void)At; (void)B0; (void)B1; (void)At8; (void)B08; (void)B18;
    const char* cA = (const char*)g.A + (size_t)cur.pm * tstep; const char* cB = (const char*)g.Bt + (size_t)cur.pn * tstep;
    S.a_ready(cur);
    if constexpr (SP2) {
        PG8_STAGE(PG8_SB(0, 0), cB, voffB); PG8_STAGE(PG8_SB(0, 1), cB + hstep, voffB); PG8_STAGE(PG8_SA(0, 0), cA, voffA); PG8_STAGE(PG8_SA(0, 1), cA + hstep, voffA);
        if (wr == 1) PG8_BAR;
        PG8_WAIT_V(2); PG8_BAR;
        PG8_STAGE(PG8_SB(1, 0), cB + kstep, voffB); PG8_STAGE(PG8_SA(1, 0), cA + kstep, voffA); PG8_STAGE(PG8_SB(1, 1), cB + hstep + kstep, voffB);
        PG8_WAIT_V(6); PG8_BAR;
    } else {
        PG8_STAGE(PG8_SB(0, 0), cB, voffB); PG8_STAGE(PG8_SA(0, 0), cA, voffA); PG8_STAGE(PG8_SB(0, 1), cB + hstep, voffB); PG8_STAGE(PG8_SA(0, 1), cA + hstep, voffA);
        if (wr == 1) PG8_BAR;
        PG8_WAIT_V(4); PG8_BAR;
        PG8_STAGE(PG8_SB(1, 0), cB + kstep, voffB); PG8_STAGE(PG8_SA(1, 0), cA + kstep, voffA); PG8_STAGE(PG8_SB(1, 1), cB + hstep + kstep, voffB);
        PG8_WAIT_V(6); PG8_BAR;
    }
    for (;;) {
        const bool has_next = S.next(ui + 1, nxt);
        const char* nA = has_next ? (const char*)g.A + (size_t)nxt.pm * tstep : cA; const char* nB = has_next ? (const char*)g.Bt + (size_t)nxt.pn * tstep : cB;
        for (int t = 0; t < nt; t += 2) {
            const bool last = (t == nt - 2);
            const char* a1 = cA + (size_t)(t + 1) * kstep;
            const char* a2 = last ? nA : cA + (size_t)(t + 2) * kstep; const char* b2 = last ? nB : cB + (size_t)(t + 2) * kstep;
            const char* a3 = a2 + kstep; const char* b3 = b2 + kstep;
            if (last && has_next) S.a_ready(nxt);
            if constexpr (SP2) {
            PG8_LDB(B0, 0, 0); PG8_LDB(B1, 0, 1); PG8_SCHED; PG8_LDA(At, 0, 0); PG8_STAGE(PG8_SA(1, 1), a1 + hstep, voffA);
            PG8_WAIT_V(8); PG8_WAIT_L(0); PG8_BAR; PG8_MMA(0, 0, At, B0); PG8_MMA(0, 1, At, B1); PG8_BAR; PG8_SCHED;
            PG8_LDA(At, 0, 1); PG8_STAGE(PG8_SB(0, 0), b2, voffB); PG8_STAGE(PG8_SB(0, 1), b2 + hstep, voffB); PG8_STAGE(PG8_SA(0, 0), a2, voffA);
            PG8_WAIT_V(8); PG8_WAIT_L(0); PG8_BAR; PG8_MMA(1, 0, At, B0); PG8_MMA(1, 1, At, B1); PG8_BAR; PG8_SCHED;
            PG8_LDB(B0, 1, 0); PG8_LDB(B1, 1, 1); PG8_SCHED; PG8_LDA(At, 1, 0); PG8_STAGE(PG8_SA(0, 1), a2 + hstep, voffA);
            PG8_WAIT_V(8); PG8_WAIT_L(0); PG8_BAR; PG8_MMA(0, 0, At, B0); PG8_MMA(0, 1, At, B1); PG8_BAR; PG8_SCHED;
            PG8_LDA(At, 1, 1); PG8_STAGE(PG8_SB(1, 0), b3, voffB); PG8_STAGE(PG8_SB(1, 1), b3 + hstep, voffB); PG8_STAGE(PG8_SA(1, 0), a3, voffA);
            PG8_WAIT_V(8); PG8_WAIT_L(0); PG8_BAR; PG8_MMA(1, 0, At, B0); PG8_MMA(1, 1, At, B1); PG8_BAR; PG8_SCHED;
            } else {
            PG8_LDB(B0, 0, 0); PG8_SCHED; PG8_LDA(At, 0, 0); PG8_STAGE(PG8_SA(1, 1), a1 + hstep, voffA);
            PG8_WAIT_L(8); PG8_BAR; PG8_WAIT_L(0); PG8_MMA(0, 0, At, B0); PG8_BAR; PG8_SCHED;
            PG8_LDB(B1, 0, 1); PG8_STAGE(PG8_SB(0, 0), b2, voffB);
            PG8_BAR; PG8_WAIT_L(0); PG8_MMA(0, 1, At, B1); PG8_BAR;
            PG8_LDA(At, 0, 1); PG8_STAGE(PG8_SA(0, 0), a2, voffA);
            PG8_BAR; PG8_WAIT_L(0); PG8_MMA(1, 0, At, B0); PG8_BAR; PG8_SCHED;
            PG8_STAGE(PG8_SB(0, 1), b2 + hstep, voffB);
            PG8_WAIT_V(6); PG8_BAR; PG8_MMA(1, 1, At, B1); PG8_BAR;
            PG8_LDB(B0, 1, 0); PG8_SCHED; PG8_LDA(At, 1, 0); PG8_STAGE(PG8_SA(0, 1), a2 + hstep, voffA);
            PG8_WAIT_L(8); PG8_BAR; PG8_WAIT_L(0); PG8_MMA(0, 0, At, B0); PG8_BAR; PG8_SCHED;
            PG8_LDB(B1, 1, 1); PG8_STAGE(PG8_SB(1, 0), b3, voffB);
            PG8_BAR; PG8_WAIT_L(0); PG8_MMA(0, 1, At, B1); PG8_BAR;
            PG8_LDA(At, 1, 1); PG8_STAGE(PG8_SA(1, 0), a3, voffA);
            PG8_BAR; PG8_WAIT_L(0); PG8_MMA(1, 0, At, B0); PG8_BAR; PG8_SCHED;
            PG8_STAGE(PG8_SB(1, 1), b3 + hstep, voffB);
            PG8_WAIT_V(6); PG8_BAR; PG8_MMA(1, 1, At, B1); PG8_BAR;
            }
        }
        if constexpr (F8) { asm volatile("s_nop 15\n\ts_nop 15" ::: "memory"); }
        if constexpr (ALIGN_EPI) { if (wr == 0) PG8_BAR; }
        if constexpr (!Epi::AFTER_DRAIN) { E(acc, cur, wr, wc, fr, fq); S.done(cur); }
        if (!has_next) break;
#pragma unroll
        for (int a = 0; a < 2; ++a)
#pragma unroll
            for (int b = 0; b < 2; ++b)
#pragma unroll
                for (int m = 0; m < 4; ++m)
#pragma unroll
                    for (int n = 0; n < 2; ++n) acc[a][b][m][n] = (f32x4){0.f, 0.f, 0.f, 0.f};
        cur = nxt; cA = nA; cB = nB; ++ui;
        if constexpr (ALIGN_EPI) { if (wr == 1) PG8_BAR; }
    }
    PG8_WAIT_V(0);
    if constexpr (!ALIGN_EPI) { if (wr == 0) PG8_BAR; }
    PG8_BAR;
    if constexpr (Epi::AFTER_DRAIN) { E.fused(acc, cur, wr, wc, fr, fq, lds, wid, lane); S.done(cur); }
#undef PG8_SA
#undef PG8_SB
#undef PG8_STAGE
#undef PG8_LDA
#undef PG8_LDB
#undef PG8_MMA
#undef PG8_WAIT_V
#undef PG8_WAIT_L
#undef PG8_BAR
#undef PG8_SCHED
}
}

#define LAS __attribute__((address_space(3)))
typedef unsigned short bf16;
typedef unsigned v4u __attribute__((ext_vector_type(4)));
typedef unsigned v2u __attribute__((ext_vector_type(2)));
typedef float f32x4 __attribute__((ext_vector_type(4)));
typedef float f32x2 __attribute__((ext_vector_type(2)));
typedef short bf16x8 __attribute__((ext_vector_type(8)));
constexpr int NB = 16, SEQ = 2048, D = 2048, M = NB * SEQ, DFF = 8192, NIN = 3584, PW = pg8::PW, NMOD = 12288;
constexpr float LN_EPS = 1e-5f, ALPHA = 1.4142135623730951f;
constexpr int NWAVES = 8, NTHR = 512;
constexpr int LDS_BYTES = 147456;
constexpr size_t MiB = 1u << 20;
constexpr size_t WS_MOD = 0;
constexpr size_t WS_WPOOL = 3 * MiB / 2;
constexpr size_t WS_WSGU = 2 * MiB;
constexpr size_t WS_WIN = 4 * MiB, WS_WOUT = 32 * MiB, WS_WFF1 = 48 * MiB, WS_WFF2 = 112 * MiB;
constexpr size_t WS_H = 176 * MiB;
constexpr size_t WS_BIG = 304 * MiB;
constexpr size_t WS_P = WS_BIG, WS_Y = WS_BIG + 224 * MiB;
constexpr size_t WS_R = WS_BIG + 512 * MiB;
constexpr size_t WS_PART = WS_R + 128 * MiB;
constexpr size_t WS_BAR = 3 * MiB, BAR_BYTES = 16384;
constexpr int LDS_BARW = 139264;
constexpr size_t WS_RSTAT = 5 * MiB / 2;
constexpr size_t WS_END = WS_PART + 8 * MiB;

#define LDS_WAIT() asm volatile("s_waitcnt lgkmcnt(0)" ::: "memory")
__device__ __forceinline__ unsigned pk2(float lo, float hi) { return pg8::cvt_pk_bf16(lo, hi); }
__device__ __forceinline__ float bflo(unsigned w) { return __uint_as_float(w << 16); }
__device__ __forceinline__ float bfhi(unsigned w) { return __uint_as_float(w & 0xffff0000u); }
__device__ __forceinline__ float wave_sum(float v) {
#pragma unroll
    for (int o = 1; o < 64; o <<= 1) v += __shfl_xor(v, o);
    return v;
}

struct Args { const float* in[22]; float* out; unsigned char* ws; int ph_lo, ph_hi; };

__device__ __forceinline__ void transpose_item(const float* W, int ldw, int K, int srccol0, bf16* WT, int dstrow0, int k0, LAS float* scr, int lane) {
#pragma unroll 8
    for (int i = 0; i < 32; ++i) { const int kk = 2 * i + (lane >> 5); scr[kk * 33 + (lane & 31)] = W[(size_t)(k0 + kk) * ldw + srccol0 + (lane & 31)]; }
    LDS_WAIT();
    const int c = lane & 7;
#pragma unroll
    for (int j = 0; j < 4; ++j) { const int n = (lane >> 3) + 8 * j; const LAS float* s = scr + (8 * c) * 33 + n;
        v4u o; o.x = pk2(s[0 * 33], s[1 * 33]); o.y = pk2(s[2 * 33], s[3 * 33]); o.z = pk2(s[4 * 33], s[5 * 33]); o.w = pk2(s[6 * 33], s[7 * 33]);
        *(v4u*)(WT + (size_t)(dstrow0 + n) * K + k0 + 8 * c) = o; }
    LDS_WAIT();
}
constexpr int FP8_OUT_LAYER = 1;
__device__ __forceinline__ void transpose_item_f8(const float* W, int ldw, int K, int srccol0, unsigned char* WT8, int dstrow0, int k0, float scl, LAS float* scr, int lane) {
#pragma unroll 8
    for (int i = 0; i < 32; ++i) { const int kk = 2 * i + (lane >> 5); scr[kk * 33 + (lane & 31)] = W[(size_t)(k0 + kk) * ldw + srccol0 + (lane & 31)]; }
    LDS_WAIT();
    const int c = lane & 7;
#pragma unroll
    for (int j = 0; j < 4; ++j) { const int n = (lane >> 3) + 8 * j; const LAS float* sp = scr + (8 * c) * 33 + n;
        int w0 = 0, w1 = 0; w0 = __builtin_amdgcn_cvt_pk_fp8_f32(sp[0 * 33] * scl, sp[1 * 33] * scl, w0, false); w0 = __builtin_amdgcn_cvt_pk_fp8_f32(sp[2 * 33] * scl, sp[3 * 33] * scl, w0, true);
        w1 = __builtin_amdgcn_cvt_pk_fp8_f32(sp[4 * 33] * scl, sp[5 * 33] * scl, w1, false); w1 = __builtin_amdgcn_cvt_pk_fp8_f32(sp[6 * 33] * scl, sp[7 * 33] * scl, w1, true);
        *(v2u*)(WT8 + (size_t)(dstrow0 + n) * K + k0 + 8 * c) = (v2u){(unsigned)w0, (unsigned)w1}; }
    LDS_WAIT();
}
__device__ __forceinline__ void prologue_phase(LAS unsigned char* lds, const __attribute__((address_space(4))) Args* ap, int tid, int wave, int lane) {
    unsigned char* ws = ap->ws;
    {
        LAS float* CA = (LAS float*)lds;
        const float* c = ap->in[1]; const float* wm = ap->in[2]; const float* bm = ap->in[3]; float* mod = (float*)(ws + WS_MOD);
        for (int it = blockIdx.x; it < 192; it += gridDim.x) {
            for (int i = tid; i < NB * D; i += NTHR) { const int b = i >> 11, k = i & 2047; const float v = c[i]; CA[k * 16 + b] = v * __builtin_amdgcn_rcpf(1.0f + __builtin_amdgcn_exp2f(v * -1.4426950408889634f)); }
            __syncthreads();
            const int gc0 = it * 128, l = gc0 / NMOD, j0 = gc0 % NMOD, ks = tid >> 5, cl = tid & 31;
            const float* wp = wm + (size_t)l * D * NMOD + (size_t)(ks * 128) * NMOD + j0 + cl * 4;
            f32x4 acc[16];
#pragma unroll
            for (int b = 0; b < 16; ++b) acc[b] = (f32x4){0.f, 0.f, 0.f, 0.f};
#pragma unroll 4
            for (int k = 0; k < 128; ++k) {
                const f32x4 w = *(const f32x4*)(wp + (size_t)k * NMOD);
                const LAS f32x4* cp = (const LAS f32x4*)(CA + (ks * 128 + k) * 16);
#pragma unroll
                for (int q = 0; q < 4; ++q) { const f32x4 cv = cp[q];
#pragma unroll
                    for (int e = 0; e < 4; ++e) acc[q * 4 + e] += w * cv[e]; }
            }
            __syncthreads();
#pragma unroll
            for (int b = 0; b < 16; ++b) *(LAS f32x4*)(CA + (ks * 16 + b) * 128 + cl * 4) = acc[b];
            __syncthreads();
            for (int o = tid; o < 16 * 128; o += NTHR) { const int b = o >> 7, cc = o & 127; float s = bm[(size_t)l * NMOD + j0 + cc];
#pragma unroll
                for (int q = 0; q < 16; ++q) s += CA[(q * 16 + b) * 128 + cc];
                mod[((size_t)l * NB + b) * NMOD + j0 + cc] = s; }
            __syncthreads();
        }
    }
    {
        bf16* wpl = (bf16*)(ws + WS_WPOOL); const float* wp = ap->in[5]; const float* ls = ap->in[6];
        for (int i = blockIdx.x * NTHR + tid; i < 2 * 4 * 128 * 128; i += gridDim.x * NTHR) { const int c = i & 127, d = (i >> 7) & 127, lg = i >> 14;
            wpl[i] = (bf16)(pk2(wp[((size_t)lg * 128 + c) * 128 + d] * ls[lg * 128 + d], 0.f) & 0xffffu); }
        bf16* wsg = (bf16*)(ws + WS_WSGU); const float* wsf = ap->in[11];
        for (int i = blockIdx.x * NTHR + tid; i < 2 * 6 * 128 * 128; i += gridDim.x * NTHR) { const int s = i & 127, t = (i >> 7) & 127;
            wsg[i] = (bf16)(pk2(s <= t ? wsf[i] : 0.f, 0.f) & 0xffffu); }
    }
    {
        LAS float* scr = (LAS float*)(lds + wave * 16384);
        const int gw = blockIdx.x * NWAVES + wave, NGW = gridDim.x * NWAVES;
        constexpr int I_IN = 32 * 112, I_OUT = 32 * 64, I_F1 = 32 * 256, I_F2 = 128 * 64, I_L = I_IN + I_OUT + I_F1 + I_F2;
        for (int it = gw; it < 2 * I_L; it += NGW) {
            const int l = it / I_L; int r = it % I_L;
            if (r < I_IN) { const int kb = r / 112, n0 = (r % 112) * 32, tile = n0 >> 8, within = n0 & 255;
                const int src = (tile >= 2 && tile < 8) ? 512 + (within >> 7) * 768 + (tile - 2) * 128 + (within & 127) : n0;
                transpose_item(ap->in[4] + (size_t)l * D * NIN, NIN, D, src, (bf16*)(ws + WS_WIN) + (size_t)l * NIN * D, n0, kb * 64, scr, lane); continue; }
            r -= I_IN;
            if (r < I_OUT) { if (l == FP8_OUT_LAYER) transpose_item_f8(ap->in[15] + (size_t)l * D * D, D, D, (r % 64) * 32, (unsigned char*)((bf16*)(ws + WS_WOUT) + (size_t)l * D * D), (r % 64) * 32, (r / 64) * 64, 64.0f, scr, lane);
                else transpose_item(ap->in[15] + (size_t)l * D * D, D, D, (r % 64) * 32, (bf16*)(ws + WS_WOUT) + (size_t)l * D * D, (r % 64) * 32, (r / 64) * 64, scr, lane); continue; }
            r -= I_OUT;
            if (r < I_F1) { transpose_item(ap->in[18] + (size_t)l * D * DFF, DFF, D, (r % 256) * 32, (bf16*)(ws + WS_WFF1) + (size_t)l * DFF * D, (r % 256) * 32, (r / 256) * 64, scr, lane); continue; }
            r -= I_F1;
            transpose_item(ap->in[19] + (size_t)l * DFF * D, D, DFF, (r % 64) * 32, (bf16*)(ws + WS_WFF2) + (size_t)l * D * DFF, (r % 64) * 32, (r / 64) * 64, scr, lane);
        }
    }
}

template <bool SRCH> struct LnRow { typedef f32x4 T; static __device__ __forceinline__ f32x4 up(const f32x4 v) { return v; } };
template <> struct LnRow<true> { typedef v2u T; static __device__ __forceinline__ f32x4 up(const v2u v) { const pg8::f32x2_cv a = pg8::up_h2(v.x), b = pg8::up_h2(v.y); return (f32x4){a.x, a.y, b.x, b.y}; } };
template <bool SRCH, bool STATS, bool WX, bool WH>
__device__ __forceinline__ void lnmod_phase(const void* srcv, float* xout, bf16* hout, const float* g, const float* bt, const float* shift, const float* scale, const float* part, float* rstat, int wave, int lane) {
    typedef typename LnRow<SRCH>::T RT;
    const RT* src = (const RT*)srcv;
    const int gw = blockIdx.x * NWAVES + wave, NGW = gridDim.x * NWAVES;
    for (int blk = gw; blk < M / 16; blk += NGW) {
        const int m0 = blk * 16, b = m0 >> 11;
        f32x4 G[8], Bc[8];
#pragma unroll
        for (int j = 0; j < 8; ++j) { f32x4 gg = (f32x4){1.f, 1.f, 1.f, 1.f}, bb = (f32x4){0.f, 0.f, 0.f, 0.f};
            if (STATS) { gg = *((const f32x4*)g + 64 * j + lane); bb = *((const f32x4*)bt + 64 * j + lane); }
            if (WH) { const f32x4 sc = *((const f32x4*)(scale + (size_t)b * NMOD) + 64 * j + lane) + 1.0f, sh = *((const f32x4*)(shift + (size_t)b * NMOD) + 64 * j + lane); gg = gg * sc; bb = bb * sc + sh; }
            G[j] = gg; Bc[j] = bb; }
        RT cur[8], nxt[8]; f32x2 pc = (f32x2){0.f, 0.f}, pn = (f32x2){0.f, 0.f};
        { const RT* xr = src + (size_t)m0 * 512 + lane;
#pragma unroll
          for (int j = 0; j < 8; ++j) { cur[j] = xr[64 * j]; nxt[j] = cur[j]; }
          if (STATS && lane < 32) pc = *((const f32x2*)(part + (size_t)m0 * 64) + lane); }
        for (int i = 0; i < 16; ++i) {
            const int m = m0 + i;
            if (i < 15) { const RT* xr = src + (size_t)(m + 1) * 512 + lane;
#pragma unroll
                for (int j = 0; j < 8; ++j) nxt[j] = xr[64 * j];
                if (STATS && lane < 32) pn = *((const f32x2*)(part + (size_t)(m + 1) * 64) + lane); }
            float mean = 0.f, rstd = 1.f;
            if (STATS) { const float S = wave_sum(pc.x), Q = wave_sum(pc.y); mean = S * (1.f / D); const float var = fmaxf(Q * (1.f / D) - mean * mean, 0.f); rstd = 1.0f / sqrtf(var + LN_EPS);
                if (!WX && lane == 0) *(f32x2*)(rstat + 2 * (size_t)m) = (f32x2){mean, rstd}; }
            const float ms = mean * rstd;
            if (WX) { f32x4* xo = (f32x4*)(xout + (size_t)m * D) + lane;
#pragma unroll
                for (int j = 0; j < 8; ++j) xo[64 * j] = (LnRow<SRCH>::up(cur[j]) * rstd - ms) * G[j] + Bc[j]; }
            if (WH) { v2u* ho = (v2u*)(hout + (size_t)m * D) + lane;
#pragma unroll
                for (int j = 0; j < 8; ++j) { const f32x4 h = (LnRow<SRCH>::up(cur[j]) * rstd - ms) * G[j] + Bc[j]; v2u w; w.x = pk2(h[0], h[1]); w.y = pk2(h[2], h[3]); ho[64 * j] = w; } }
#pragma unroll
            for (int j = 0; j < 8; ++j) cur[j] = nxt[j];
            pc = pn;
        }
    }
}

__device__ __forceinline__ void y_store4(bf16* Y, bool y8, size_t row, int col, float a, float b, float c, float d) {
    if (y8) { int wq = 0; wq = __builtin_amdgcn_cvt_pk_fp8_f32(a, b, wq, false); wq = __builtin_amdgcn_cvt_pk_fp8_f32(c, d, wq, true); *(unsigned*)((unsigned char*)Y + row * 2048 + col) = (unsigned)wq; }
    else { v2u o; o.x = pk2(a, b); o.y = pk2(c, d); *(v2u*)(Y + row * 2048 + col) = o; }
}
struct MixW { bool y8; const bf16* wpoolT; const bf16* wsgu; const float* bsgu; const float* lsg; const float* lsb; const float* cw; const float* cb; const float* lcg; const float* lcb; };

__device__ __forceinline__ void sgu_unit(LAS unsigned char* lds, const bf16* P, bf16* Y, const MixW& w, int r0, int tid, int wave, int lane) {
    LAS float* ST = (LAS float*)lds;
    LAS bf16* VT = (LAS bf16*)(lds + 1024);
    for (int i = 0; i < 16; ++i) { const int t = wave * 16 + i; const bf16* vr = P + (size_t)(r0 + t) * PW + 2048;
        float x[12];
#pragma unroll
        for (int k = 0; k < 3; ++k) { const v2u q = *(const v2u*)(vr + k * 256 + lane * 4); x[4 * k] = bflo(q.x); x[4 * k + 1] = bfhi(q.x); x[4 * k + 2] = bflo(q.y); x[4 * k + 3] = bfhi(q.y); }
        float s = 0.f;
#pragma unroll
        for (int k = 0; k < 12; ++k) s += x[k];
        const float mean = wave_sum(s) * (1.f / 768.f); float qq = 0.f;
#pragma unroll
        for (int k = 0; k < 12; ++k) { const float dlt = x[k] - mean; qq += dlt * dlt; }
        const float rstd = 1.0f / sqrtf(wave_sum(qq) * (1.f / 768.f) + LN_EPS);
        if (lane == 0) { ST[2 * t] = mean; ST[2 * t + 1] = rstd; } }
    __syncthreads();
    for (int h = 0; h < 6; ++h) {
        { const int s = tid & 127, dg = tid >> 7; const bf16* vr = P + (size_t)(r0 + s) * PW + 2048 + h * 128 + dg * 32; const float mean = ST[2 * s], rstd = ST[2 * s + 1];
          const float* gp = w.lsg + h * 128 + dg * 32; const float* bp = w.lsb + h * 128 + dg * 32;
#pragma unroll
          for (int q = 0; q < 4; ++q) { const v4u xw = *(const v4u*)(vr + q * 8); const unsigned ww[4] = {xw.x, xw.y, xw.z, xw.w};
#pragma unroll
              for (int e = 0; e < 4; ++e) { const int d = dg * 32 + q * 8 + 2 * e;
                  const float y0 = (bflo(ww[e]) - mean) * rstd * gp[q * 8 + 2 * e] + bp[q * 8 + 2 * e], y1 = (bfhi(ww[e]) - mean) * rstd * gp[q * 8 + 2 * e + 1] + bp[q * 8 + 2 * e + 1];
                  const unsigned pkd = pk2(y0, y1); VT[d * 136 + s] = (bf16)(pkd & 0xffffu); VT[(d + 1) * 136 + s] = (bf16)(pkd >> 16); } } }
        __syncthreads();
        const int nkb = (wave >> 1) + 1;
        f32x4 acc[8];
#pragma unroll
        for (int db = 0; db < 8; ++db) acc[db] = (f32x4){0.f, 0.f, 0.f, 0.f};
        for (int kb = 0; kb < nkb; ++kb) {
            const bf16x8 yf = *(const bf16x8*)(w.wsgu + ((size_t)(h * 128 + wave * 16 + (lane & 15))) * 128 + kb * 32 + (lane >> 4) * 8);
#pragma unroll
            for (int db = 0; db < 8; ++db) { const bf16x8 xf = *(const LAS bf16x8*)(VT + (db * 16 + (lane & 15)) * 136 + kb * 32 + (lane >> 4) * 8);
                acc[db] = __builtin_amdgcn_mfma_f32_16x16x32_bf16(xf, yf, acc[db], 0, 0, 0); }
        }
        { const int t = wave * 16 + (lane & 15); const float bias = w.bsgu[h * 128 + t];
          const bf16* up = P + (size_t)(r0 + t) * PW + 1280 + h * 128 + (lane >> 4) * 4; bf16* yp = Y + (size_t)(r0 + t) * D + 1280 + h * 128 + (lane >> 4) * 4;
#pragma unroll
          for (int db = 0; db < 8; ++db) { const v2u uw = *(const v2u*)(up + db * 16);
              y_store4(Y, w.y8, (size_t)(r0 + t), 1280 + h * 128 + (lane >> 4) * 4 + db * 16, bflo(uw.x) * (acc[db][0] + bias), bfhi(uw.x) * (acc[db][1] + bias), bflo(uw.y) * (acc[db][2] + bias), bfhi(uw.y) * (acc[db][3] + bias)); } (void)yp; }
        __syncthreads();
    }
}

template <int G> __device__ __forceinline__ void pool_group(const bf16* P, bf16* Y, const MixW& w, int r0, int wave, int lane) {
    constexpr int win = 2 << G;
    const int t = wave * 16 + (lane & 15), kq = lane >> 4, pos = (r0 & (SEQ - 1)) + t;
    const bf16* prow = P + (size_t)(r0 + t) * PW + G * 128 + kq * 8;
    const float inv = 1.0f / (float)min(pos + 1, win);
    f32x4 acc[8];
#pragma unroll
    for (int db = 0; db < 8; ++db) acc[db] = (f32x4){0.f, 0.f, 0.f, 0.f};
#pragma unroll 1
    for (int kb = 0; kb < 4; ++kb) {
        float sacc[8], self[8];
#pragma unroll
        for (int e = 0; e < 8; ++e) { sacc[e] = 0.f; self[e] = 0.f; }
#pragma unroll
        for (int j = 0; j < win; ++j) { v4u q = (v4u){0u, 0u, 0u, 0u}; if (pos - j >= 0) q = *(const v4u*)(prow - (size_t)j * PW + kb * 32);
            const unsigned ww[4] = {q.x, q.y, q.z, q.w};
#pragma unroll
            for (int e = 0; e < 4; ++e) { const float lo = bflo(ww[e]), hi = bfhi(ww[e]); sacc[2 * e] += lo; sacc[2 * e + 1] += hi; if (j == 0) { self[2 * e] = lo; self[2 * e + 1] = hi; } } }
        v4u o; o.x = pk2(sacc[0] * inv - self[0], sacc[1] * inv - self[1]); o.y = pk2(sacc[2] * inv - self[2], sacc[3] * inv - self[3]);
        o.z = pk2(sacc[4] * inv - self[4], sacc[5] * inv - self[5]); o.w = pk2(sacc[6] * inv - self[6], sacc[7] * inv - self[7]);
        const bf16x8 yf = __builtin_bit_cast(bf16x8, o);
#pragma unroll
        for (int db = 0; db < 8; ++db) { const bf16x8 xf = *(const bf16x8*)(w.wpoolT + ((size_t)(G * 128 + db * 16 + (lane & 15))) * 128 + kb * 32 + kq * 8);
            acc[db] = __builtin_amdgcn_mfma_f32_16x16x32_bf16(xf, yf, acc[db], 0, 0, 0); }
    }
    bf16* yp = Y + (size_t)(r0 + t) * D + G * 128 + kq * 4;
#pragma unroll
    for (int db = 0; db < 8; ++db) y_store4(Y, w.y8, (size_t)(r0 + t), G * 128 + kq * 4 + db * 16, acc[db][0], acc[db][1], acc[db][2], acc[db][3]);
    (void)yp;
}

__device__ __forceinline__ void conv_wave(LAS unsigned char* lds, const bf16* P, bf16* Y, const MixW& w, int r0, int wave, int lane) {
    LAS unsigned* CO = (LAS unsigned*)(lds + wave * 12288);
    for (int pass = 0; pass < 2; ++pass) {
        const int tb = r0 + wave * 16 + pass * 8, posb = tb & (SEQ - 1);
        unsigned xn[38];
        { const unsigned* xp = (const unsigned*)(P + (size_t)tb * PW + 512) + lane;
#pragma unroll
          for (int i = 0; i < 38; ++i) { xn[i] = 0u; if (posb - 30 + i >= 0) xn[i] = *(xp + (ptrdiff_t)(i - 30) * (PW / 2)); } }
#pragma unroll 1
        for (int slab = 0; slab < 6; ++slab) {
            f32x2 wv[31];
#pragma unroll
            for (int j = 0; j < 31; ++j) wv[j] = *(const f32x2*)(w.cw + j * 768 + slab * 128 + 2 * lane);
            const f32x2 cbv = *(const f32x2*)(w.cb + slab * 128 + 2 * lane);
            f32x2 xs[38];
#pragma unroll
            for (int i = 0; i < 38; ++i) xs[i] = (f32x2){bflo(xn[i]), bfhi(xn[i])};
            if (slab < 5) { const unsigned* xp = (const unsigned*)(P + (size_t)tb * PW + 512 + (slab + 1) * 128) + lane;
#pragma unroll
                for (int i = 0; i < 38; ++i) { xn[i] = 0u; if (posb - 30 + i >= 0) xn[i] = *(xp + (ptrdiff_t)(i - 30) * (PW / 2)); } }
#pragma unroll
            for (int tt = 0; tt < 8; ++tt) { f32x2 o = cbv;
#pragma unroll
                for (int j = 0; j < 31; ++j) o += xs[tt + j] * wv[j];
                CO[tt * 384 + slab * 64 + lane] = pk2(o.x, o.y); }
        }
#pragma unroll
        for (int tt = 0; tt < 8; ++tt) {
            v2u qq[3]; float sa = 0.f, sb = 0.f;
#pragma unroll
            for (int k = 0; k < 3; ++k) { qq[k] = *(const LAS v2u*)(CO + tt * 384 + k * 128 + lane * 2);
                const float a0 = bflo(qq[k].x), a1 = bfhi(qq[k].x), a2 = bflo(qq[k].y), a3 = bfhi(qq[k].y); sa += (a0 + a1) + (a2 + a3); sb += (a0 * a0 + a1 * a1) + (a2 * a2 + a3 * a3); }
            const float mean = wave_sum(sa) * (1.f / 768.f); const float var = fmaxf(wave_sum(sb) * (1.f / 768.f) - mean * mean, 0.f); const float rstd = 1.0f / sqrtf(var + LN_EPS);
            bf16* yp = Y + (size_t)(tb + tt) * D + 512;
#pragma unroll
            for (int k = 0; k < 3; ++k) { const int c = k * 256 + lane * 4; const v2u q = qq[k];
                const f32x4 gg = *(const f32x4*)(w.lcg + c), bb = *(const f32x4*)(w.lcb + c);
                float y[4] = {bflo(q.x), bfhi(q.x), bflo(q.y), bfhi(q.y)};
#pragma unroll
                for (int e = 0; e < 4; ++e) { const float z = (y[e] - mean) * rstd * gg[e] + bb[e]; y[e] = z * __builtin_amdgcn_rcpf(1.0f + __builtin_amdgcn_exp2f(z * -1.4426950408889634f)); }
                y_store4(Y, w.y8, (size_t)(tb + tt), 512 + c, y[0], y[1], y[2], y[3]); } (void)yp; }
    }
}

__device__ __forceinline__ void mixer_phase(LAS unsigned char* lds, const bf16* P, bf16* Y, const MixW& w, int tid, int wave, int lane) {
    for (int u = blockIdx.x; u < M / 128; u += gridDim.x) {
        const int r0 = u * 128;
#ifndef REP_SGU
#define REP_SGU 0
#endif
#ifndef REP_PC
#define REP_PC 0
#endif
        for (int rep = 0; rep <= REP_SGU; ++rep)
        sgu_unit(lds, P, Y, w, r0, tid, wave, lane);
        for (int rep = 0; rep < REP_PC; ++rep) { pool_group<0>(P, Y, w, r0, wave, lane); pool_group<1>(P, Y, w, r0, wave, lane); pool_group<2>(P, Y, w, r0, wave, lane); pool_group<3>(P, Y, w, r0, wave, lane); }
        pool_group<0>(P, Y, w, r0, wave, lane); pool_group<1>(P, Y, w, r0, wave, lane); pool_group<2>(P, Y, w, r0, wave, lane); pool_group<3>(P, Y, w, r0, wave, lane);
#ifndef REP_CV
#define REP_CV 0
#endif
        for (int rep = 0; rep <= REP_CV; ++rep)
        conv_wave(lds, P, Y, w, r0, wave, lane);
        __syncthreads();
    }
}

#define XB_TMO      128
#define XB_XCNT(j)  (256  + 64 * (j))
#define XB_XSUB(j)  (1280 + 64 * (j))
#define XB_XGEN(j)  (2304 + 64 * (j))
#define XB_TOP      3328
#define XB_TOPGEN   3392
#define XCD_BAR_WORDS 3456
#define XB_SPIN_CAP (1u << 18)

__device__ __forceinline__ unsigned xb_ld(unsigned* p)              { return __hip_atomic_load(p, __ATOMIC_RELAXED, __HIP_MEMORY_SCOPE_AGENT); }
__device__ __forceinline__ unsigned xb_add(unsigned* p, unsigned v) { return __hip_atomic_fetch_add(p, v, __ATOMIC_RELAXED, __HIP_MEMORY_SCOPE_AGENT); }
__device__ __forceinline__ unsigned xb_xcc_id() { return (unsigned)__builtin_amdgcn_s_getreg((3 << 11) | 20) & 0xFu; }
#define XB_SPIN(cond, bar) do { unsigned _sp = 0; while (cond) { \
    if ((++_sp & 255u) == 0u) { if (xb_ld(&(bar)[XB_TMO])) break; if (_sp > XB_SPIN_CAP) { atomicAdd(&(bar)[XB_TMO], 1u); break; } } } } while (0)

struct XcdBarrier {
    unsigned* bar; unsigned x;
    volatile LAS unsigned* st;
};

__device__ __forceinline__ XcdBarrier xcd_barrier_post(unsigned* bar, volatile LAS unsigned* st) {
    XcdBarrier b; b.bar = bar; b.x = xb_xcc_id(); b.st = st;
    if (threadIdx.x == 0) (void)xb_add(&bar[XB_XCNT(b.x)], 1u);
    return b;
}
__device__ __forceinline__ void xcd_barrier_complete(unsigned* bar, unsigned x, unsigned& nloc, unsigned& nx) {
    const unsigned G = gridDim.x * gridDim.y * gridDim.z;
    unsigned sum, cnt, mine, sp = 0u;
    for (;;) {
        sum = 0u; cnt = 0u; mine = 0u;
#pragma unroll
        for (unsigned j = 0; j < 16; ++j) { const unsigned c = xb_ld(&bar[XB_XCNT(j)]); sum += c; cnt += (c > 0u) ? 1u : 0u; mine = (j == x) ? c : mine; }
        if (sum == G) break;
        __builtin_amdgcn_s_sleep(1);
        if ((++sp & 255u) == 0u) { if (xb_ld(&bar[XB_TMO])) break; if (sp > XB_SPIN_CAP) { atomicAdd(&bar[XB_TMO], 1u); break; } }
    }
    nloc = mine > 0u ? mine : 1u; nx = cnt > 0u ? cnt : 1u;
}

__device__ __forceinline__ void xcd_barrier(const XcdBarrier& b) {
    asm volatile("s_waitcnt vmcnt(0)" ::: "memory");
    __syncthreads();
    if (threadIdx.x == 0) {
        unsigned* bar = b.bar;
        __builtin_amdgcn_s_waitcnt(0);
        unsigned nloc = b.st[0], nx = b.st[1];
        if (nloc == 0u) { xcd_barrier_complete(bar, b.x, nloc, nx); b.st[0] = nloc; b.st[1] = nx; }
        const unsigned old = xb_add(&bar[XB_XSUB(b.x)], 1u);
        const unsigned gen = old / nloc;
        if (old + 1u == (gen + 1u) * nloc) {
            __builtin_amdgcn_fence(__ATOMIC_RELEASE, "agent");
            asm volatile("s_waitcnt vmcnt(0)" ::: "memory");
            const unsigned og = xb_add(&bar[XB_TOP], 1u);
            const unsigned tg = og / nx;
            if (og + 1u == (tg + 1u) * nx) xb_add(&bar[XB_TOPGEN], 1u);
            else XB_SPIN(xb_ld(&bar[XB_TOPGEN]) == tg, bar);
            __builtin_amdgcn_fence(__ATOMIC_ACQUIRE, "agent");
            xb_add(&bar[XB_XGEN(b.x)], 1u);
            asm volatile("s_waitcnt vmcnt(0)" ::: "memory");
        } else {
            XB_SPIN(xb_ld(&bar[XB_XGEN(b.x)]) == gen, bar);
            __builtin_amdgcn_fence(__ATOMIC_ACQUIRE, "agent");
            asm volatile("s_waitcnt vmcnt(0)" ::: "memory");
        }
    }
    __syncthreads();
}

#define AS4 __attribute__((address_space(4)))
#define PHASE_BEGIN const AS4 Args* ap = (const AS4 Args*)__builtin_amdgcn_kernarg_segment_ptr(); asm volatile("" : "+s"(ap)); \
    int tid = threadIdx.x; asm volatile("" : "+v"(tid)); const int lane = tid & 63, wave = __builtin_amdgcn_readfirstlane(tid >> 6); (void)lane; (void)wave; \
    unsigned char* ws = ap->ws; (void)ws;
#ifdef DBG_TS
#define DBG_STAMP(i) do { if (blockIdx.x == 0 && threadIdx.x == 0) { const AS4 Args* ap_ = (const AS4 Args*)__builtin_amdgcn_kernarg_segment_ptr(); ((unsigned long long*)(ap_->ws + 3 * MiB))[(i)] = __builtin_amdgcn_s_memrealtime(); } } while (0)
#else
#define DBG_STAMP(i) do { } while (0)
#endif
#define RSYNC() do { xcd_barrier(bar); } while (0)
#ifndef REP_PRO
#define REP_PRO 0
#endif
#ifndef REP_MIX
#define REP_MIX 0
#endif
#ifndef REP_LN
#define REP_LN 0
#endif
#ifndef REP_FF1
#define REP_FF1 0
#endif
#ifndef REP_INP
#define REP_INP 0
#endif
#ifndef REP_OUT0
#define REP_OUT0 0
#endif
template <int L> __device__ __forceinline__ void layer_phases(LAS unsigned char* lds, const XcdBarrier& bar, const int lo, const int hi) {
#define IN(k) (lo <= (k) && (k) < hi)
#define SEAM(k) do { if (IN(k) && IN((k) + 1)) { xcd_barrier(bar); } } while (0)
    constexpr int pb = 2 + 7 * L;
    if (IN(pb)) { PHASE_BEGIN
        pg8::Gemm g{(const bf16*)(ws + WS_H), (const bf16*)(ws + WS_WIN) + (size_t)L * NIN * D, M, NIN, D}; pg8::StaticOrder S; S.init(M, NIN, (int)gridDim.x, (int)blockIdx.x);
        pg8::EpiInProj E{(bf16*)(ws + WS_P)}; for (int rep = 0; rep <= REP_INP; ++rep) { if (rep) RSYNC(); pg8::gemm_phase<pg8::EpiInProj, pg8::StaticOrder, true, true>(lds, g, S, E); } }
    SEAM(pb);
    if (IN(pb + 1)) { PHASE_BEGIN
        MixW w; w.y8 = (L == FP8_OUT_LAYER); w.wpoolT = (const bf16*)(ws + WS_WPOOL) + (size_t)L * 4 * 128 * 128; w.wsgu = (const bf16*)(ws + WS_WSGU) + (size_t)L * 6 * 128 * 128;
        w.bsgu = ap->in[12] + L * 768; w.lsg = ap->in[13] + L * 768; w.lsb = ap->in[14] + L * 768; w.cw = ap->in[7] + L * 31 * 768; w.cb = ap->in[8] + L * 768; w.lcg = ap->in[9] + L * 768; w.lcb = ap->in[10] + L * 768;
        for (int rep = 0; rep <= REP_MIX; ++rep) { if (rep) RSYNC(); mixer_phase(lds, (const bf16*)(ws + WS_P), (bf16*)(ws + WS_Y), w, tid, wave, lane); } }
    SEAM(pb + 1);
    if (IN(pb + 2)) { PHASE_BEGIN
        pg8::Gemm g{(const bf16*)(ws + WS_Y), (const bf16*)(ws + WS_WOUT) + (size_t)L * D * D, M, D, L == FP8_OUT_LAYER ? D / 2 : D}; pg8::StaticOrder S; S.init(M, D, (int)gridDim.x, (int)blockIdx.x);
        float* X = ap->out; const float* gate = (const float*)(ws + WS_MOD) + (size_t)L * NB * NMOD + 2 * D;
        bf16* R = (bf16*)(ws + WS_R); (void)X;
        if (L == 0) { pg8::EpiResid<true, false> E{ap->in[0], nullptr, nullptr, R, gate, nullptr, nullptr, nullptr, (float*)(ws + WS_PART), ALPHA, 1.0f}; for (int rep = 0; rep <= REP_OUT0; ++rep) { if (rep) RSYNC(); pg8::gemm_phase<pg8::EpiResid<true, false>, pg8::StaticOrder, true, true>(lds, g, S, E); } }
        else { pg8::EpiResid<false, false> E{nullptr, R, nullptr, R, gate, (const float*)(ws + WS_RSTAT), ap->in[20], ap->in[21], (float*)(ws + WS_PART), ALPHA, L == FP8_OUT_LAYER ? 1.0f / 64.0f : 1.0f}; pg8::gemm_phase<pg8::EpiResid<false, false>, pg8::StaticOrder, true, true, L == FP8_OUT_LAYER>(lds, g, S, E); } }
    SEAM(pb + 2);
    if (IN(pb + 3)) { PHASE_BEGIN
        float* X = ap->out; const float* modl = (const float*)(ws + WS_MOD) + (size_t)L * NB * NMOD;
        (void)X; lnmod_phase<true, true, false, true>(ws + WS_R, nullptr, (bf16*)(ws + WS_H), ap->in[16] + L * D, ap->in[17] + L * D, modl + 3 * D, modl + 4 * D, (const float*)(ws + WS_PART), (float*)(ws + WS_RSTAT), wave, lane); }
    SEAM(pb + 3);
    if (IN(pb + 4)) { PHASE_BEGIN
        pg8::Gemm g{(const bf16*)(ws + WS_H), (const bf16*)(ws + WS_WFF1) + (size_t)L * DFF * D, M, DFF, D}; pg8::StaticOrder S; S.init(M, DFF, (int)gridDim.x, (int)blockIdx.x);
#ifdef STAG_FF1
        { const unsigned long long t0 = __builtin_amdgcn_s_memrealtime(); const unsigned long long dl = (unsigned long long)(((blockIdx.x >> 3) & (STAG_N - 1)) * STAG_FF1);
          while (__builtin_amdgcn_s_memrealtime() - t0 < dl) __builtin_amdgcn_s_sleep(16); }
#endif
#ifdef PROBE_NULL
        { pg8::EpiNull E0{(bf16*)(ws + WS_BIG)}; pg8::gemm_phase<pg8::EpiNull, pg8::StaticOrder, true, true>(lds, g, S, E0); RSYNC(); }
#endif
#ifdef PROBE_CLK
        unsigned long long c0_ = 0, r0_ = 0; if (L == 0) { c0_ = __builtin_readcyclecounter(); r0_ = __builtin_amdgcn_s_memrealtime(); }
#endif
        pg8::EpiRelu2<false> E{(bf16*)(ws + WS_BIG)}; for (int rep = 0; rep <= REP_FF1; ++rep) { if (rep) RSYNC(); pg8::gemm_phase<pg8::EpiRelu2<false>, pg8::StaticOrder, true, true>(lds, g, S, E); }
#ifdef PROBE_CLK
        if (L == 0 && blockIdx.x == 0 && threadIdx.x == 0) { const unsigned long long c1_ = __builtin_readcyclecounter(), r1_ = __builtin_amdgcn_s_memrealtime();
            ((float*)(ws + 3 * MiB))[0] = (float)(c1_ - c0_) / (float)(r1_ - r0_); ((float*)(ws + 3 * MiB))[1] = (float)(r1_ - r0_) * 0.01f; }
#endif
        }
    SEAM(pb + 4);
    if (IN(pb + 5)) { PHASE_BEGIN
        pg8::Gemm g{(const bf16*)(ws + WS_BIG), (const bf16*)(ws + WS_WFF2) + (size_t)L * D * DFF, M, D, DFF}; pg8::StaticOrder S; S.init(M, D, (int)gridDim.x, (int)blockIdx.x);
        float* X = ap->out; bf16* R = (bf16*)(ws + WS_R);
        (void)X; pg8::EpiResid<false, false> E{nullptr, R, nullptr, R, (const float*)(ws + WS_MOD) + (size_t)L * NB * NMOD + 5 * D, (const float*)(ws + WS_RSTAT), ap->in[16] + L * D, ap->in[17] + L * D, (float*)(ws + WS_PART), ALPHA, 1.0f};
        pg8::gemm_phase<pg8::EpiResid<false, false>, pg8::StaticOrder, true, true>(lds, g, S, E); }
    SEAM(pb + 5);
    if (IN(pb + 6)) { PHASE_BEGIN
        float* X = ap->out; const float* mod1 = (const float*)(ws + WS_MOD) + (size_t)NB * NMOD;
        if (L == 0) lnmod_phase<true, true, false, true>(ws + WS_R, nullptr, (bf16*)(ws + WS_H), ap->in[20], ap->in[21], mod1 + 0 * D, mod1 + 1 * D, (const float*)(ws + WS_PART), (float*)(ws + WS_RSTAT), wave, lane);
        else lnmod_phase<true, true, true, false>(ws + WS_R, X, nullptr, ap->in[20] + D, ap->in[21] + D, nullptr, nullptr, (const float*)(ws + WS_PART), nullptr, wave, lane); }
    SEAM(pb + 6);
}
__global__ void __launch_bounds__(NTHR, 2) fwd_kernel(Args a_unused) {
    extern __shared__ __attribute__((aligned(16))) unsigned char lds_raw[];
    LAS unsigned char* lds = (LAS unsigned char*)lds_raw;
    cg::grid_group grid = cg::this_grid();
    int lo, hi; XcdBarrier bar; { const AS4 Args* ap0 = (const AS4 Args*)__builtin_amdgcn_kernarg_segment_ptr(); lo = ap0->ph_lo; hi = ap0->ph_hi;
        volatile LAS unsigned* stw = (volatile LAS unsigned*)(lds + LDS_BARW); if (threadIdx.x == 0) { stw[0] = 0u; stw[1] = 0u; } __syncthreads();
        bar = xcd_barrier_post((unsigned*)(ap0->ws + WS_BAR), stw); }
    if (lo < 0) grid.sync();
    DBG_STAMP(0);
    if (IN(0)) { PHASE_BEGIN for (int rep = 0; rep <= REP_PRO; ++rep) { if (rep) RSYNC(); prologue_phase(lds, ap, tid, wave, lane); } }
    SEAM(0);
    if (IN(1)) { PHASE_BEGIN for (int rep = 0; rep <= REP_LN; ++rep) { if (rep) RSYNC();
        lnmod_phase<false, false, false, true>(ap->in[0], nullptr, (bf16*)(ws + WS_H), nullptr, nullptr, (const float*)(ws + WS_MOD) + 0 * D, (const float*)(ws + WS_MOD) + 1 * D, nullptr, nullptr, wave, lane); } }
    SEAM(1);
#ifdef DBG_LAST
    if (lo >= 100) { PHASE_BEGIN
        const int which = lo - 100; const bf16* src = which == 0 ? (const bf16*)(ws + WS_H) : which == 1 ? (const bf16*)(ws + WS_P) + DBG_COL : which == 2 ? (const bf16*)(ws + WS_Y) : (const bf16*)(ws + WS_BIG) + DBG_COL;
        const int pitch = which == 0 ? D : which == 1 ? PW : which == 2 ? D : DFF; float* X = ap->out;
        for (size_t i = (size_t)blockIdx.x * NTHR + tid; i < (size_t)M * D; i += (size_t)gridDim.x * NTHR) { const size_t m = i >> 11, c = i & 2047; float v = __uint_as_float((unsigned)src[m * pitch + c] << 16); v = (!(fabsf(v) < 1e30f)) ? ((DBG_COND) ? 1000.f : 1.f) : 0.f; X[i] = v; }
        return; }
#endif
#ifdef PROBE_SYNCS
    for (int i = 0; i < PROBE_SYNCS; ++i) RSYNC();
#endif
    layer_phases<0>(lds, bar, lo, hi);
    layer_phases<1>(lds, bar, lo, hi);
#ifdef PROBE_CLK
    if (blockIdx.x == 0 && threadIdx.x == 0) { const AS4 Args* ap_ = (const AS4 Args*)__builtin_amdgcn_kernarg_segment_ptr(); const float* pr = (const float*)(ap_->ws + 3 * MiB);
        asm volatile("s_waitcnt vmcnt(0)" ::: "memory"); ap_->out[0] = rintf(pr[0] * PROBE_CLK) ; }
#endif
#ifdef DBG_TS
    DBG_STAMP(16);
    if (blockIdx.x == 0 && threadIdx.x == 0) { const AS4 Args* ap_ = (const AS4 Args*)__builtin_amdgcn_kernarg_segment_ptr(); const unsigned long long* ts = (const unsigned long long*)(ap_->ws + 3 * MiB);
        asm volatile("s_waitcnt vmcnt(0)" ::: "memory");
        float A = 0.f, B = 0.f;
        for (int k = 0; k < 16; ++k) { const float d = (float)(ts[k + 1] - ts[k]) * 0.01f; if ((DBG_TA >> k) & 1) A += d; if ((DBG_TB >> k) & 1) B += d; }
        ap_->out[0] = A / DBG_DA; ap_->out[1] = B / DBG_DB; }
#endif
#undef IN
#undef SEAM
}
constexpr int NPHASES = 16;
#ifndef MK_N_LAUNCHES
#define MK_N_LAUNCHES 1
#endif

extern "C" void kernel_launch(void* const* d_in, const int* in_sizes, int n_in, void* d_out, int out_size, void* d_ws, size_t ws_size, hipStream_t stream) {
    static int grid = 0;
    if (grid == 0) {
        if (n_in != 22 || out_size != M * D || ws_size < WS_END) { fprintf(stderr, "kernel_launch: unexpected shapes (n_in %d, out %d, ws %zu < %zu)\n", n_in, out_size, ws_size, (size_t)WS_END); grid = -1; return; }
        int dev = 0, cus = 0, per_cu = 0;
        hipGetDevice(&dev); hipDeviceGetAttribute(&cus, hipDeviceAttributeMultiprocessorCount, dev);
        if (hipFuncSetAttribute((const void*)fwd_kernel, hipFuncAttributeMaxDynamicSharedMemorySize, LDS_BYTES) != hipSuccess) { fprintf(stderr, "kernel_launch: hipFuncSetAttribute failed\n"); grid = -1; return; }
        if (hipOccupancyMaxActiveBlocksPerMultiprocessor(&per_cu, (const void*)fwd_kernel, NTHR, LDS_BYTES) != hipSuccess || per_cu < 1) { fprintf(stderr, "kernel_launch: occupancy query says %d\n", per_cu); per_cu = 1; (void)hipGetLastError(); }
        grid = cus * per_cu;
    }
    if (grid < 0) return;
    if (hipMemsetAsync((char*)d_ws + WS_BAR, 0, BAR_BYTES, stream) != hipSuccess) { fprintf(stderr, "kernel_launch: hipMemsetAsync failed\n"); return; }
    Args a{};
    for (int i = 0; i < 22; ++i) a.in[i] = (const float*)d_in[i];
    a.out = (float*)d_out; a.ws = (unsigned char*)d_ws;
    if (MK_N_LAUNCHES == 1) {
        a.ph_lo = 0; a.ph_hi = NPHASES;
        void* args[] = {&a};
        hipError_t e = hipLaunchCooperativeKernel((const void*)fwd_kernel, dim3(grid), dim3(NTHR), args, LDS_BYTES, stream);
        if (e != hipSuccess) fprintf(stderr, "kernel_launch: cooperative launch failed: %s (grid %d)\n", hipGetErrorString(e), grid);
    } else {
#ifdef DBG_LAST
        for (int p = 0; p <= DBG_LAST; ++p) { a.ph_lo = p; a.ph_hi = p + 1; hipLaunchKernelGGL(fwd_kernel, dim3(grid), dim3(NTHR), LDS_BYTES, stream, a); }
        a.ph_lo = 100 + DBG_WHICH; a.ph_hi = 0; hipLaunchKernelGGL(fwd_kernel, dim3(grid), dim3(NTHR), LDS_BYTES, stream, a);
#else
        for (int p = 0; p < NPHASES; ++p) { a.ph_lo = p; a.ph_hi = p + 1; hipLaunchKernelGGL(fwd_kernel, dim3(grid), dim3(NTHR), LDS_BYTES, stream, a); }
#endif
    }
}
```
